# Optimizing an MI355X kernel written in HIP

```python
import jax
import jax.numpy as jnp
from jax import lax
import numpy as np

D_MODEL = 1024
BATCH = 4
SEQ = 8192
DEPTH = 2

N_A_LAYERS = DEPTH // 2
N_B_LAYERS = DEPTH - N_A_LAYERS
HEAD_DIM = 64
N_HEADS_A = D_MODEL // HEAD_DIM
WIDTH_A = N_HEADS_A * HEAD_DIM
DECAY_LORA = 64
ICLR_LORA = 64
N_HEADS_B = D_MODEL // HEAD_DIM
WIDTH_B = N_HEADS_B * HEAD_DIM
MOBA_BLOCK = 256
MOBA_TOPK = 3
QUERY_CHUNK = 16
ROPE_THETA = 500000.0
ROPE_DIM = HEAD_DIM // 4
RMS_EPS = 1e-6
GN_EPS = 64e-5
NEG = -1e30

kernel_name = "yoco_rwkv7_moba_hybrid"


def rms_norm(x, g):
    xf = x.astype(jnp.float32)
    y = xf * lax.rsqrt(jnp.mean(xf * xf, axis=-1, keepdims=True) + RMS_EPS)
    return (y * g.astype(jnp.float32)).astype(x.dtype)


def rope_tables(T):
    inv_freq = jnp.power(jnp.float32(ROPE_THETA), -jnp.arange(0, ROPE_DIM, 2, dtype=jnp.float32) / ROPE_DIM)
    ang = jnp.arange(T, dtype=jnp.float32)[:, None] * inv_freq[None, :]
    return jnp.cos(ang), jnp.sin(ang)


def partial_rope(x, cos, sin):
    half = ROPE_DIM // 2
    xr = x[..., :ROPE_DIM].astype(jnp.float32)
    x1, x2 = xr[..., :half], xr[..., half:]
    rot = jnp.concatenate([x1 * cos - x2 * sin, x2 * cos + x1 * sin], axis=-1)
    return jnp.concatenate([rot.astype(x.dtype), x[..., ROPE_DIM:]], axis=-1)


def rwkv7_time_mix(h, mu, w_in, w0, w2, a0, a2, k_k, k_a, r_k, gn_w, gn_b, w_out):
    B, T, D = h.shape
    H, N = N_HEADS_A, HEAD_DIM
    xx = jnp.pad(h, ((0, 0), (1, 0), (0, 0)))[:, :-1] - h
    widths = (WIDTH_A, DECAY_LORA, WIDTH_A, WIDTH_A, ICLR_LORA, WIDTH_A)
    outs = []
    off = 0
    for i, wd in enumerate(widths):
        outs.append((h + xx * mu[i]) @ w_in[:, off:off + wd])
        off += wd
    r, wdn, k, v, adn, gp = [o.astype(jnp.float32) for o in outs]
    w = -jax.nn.softplus(-(w0 + jnp.tanh(wdn) @ w2)) - 0.5
    decay = jnp.exp(-jnp.exp(w))
    a = jax.nn.sigmoid(a0 + adn @ a2)
    kk = (k * k_k).reshape(B, T, H, N)
    kk = kk / jnp.maximum(jnp.linalg.norm(kk, axis=-1, keepdims=True), 1e-12)
    k = k * (1.0 + (a - 1.0) * k_a)

    def heads_tm(z):
        return z.reshape(B, T, H, N).transpose(1, 0, 2, 3)

    r4, d4, k4, v4 = heads_tm(r), heads_tm(decay), heads_tm(k), heads_tm(v)
    kk4 = heads_tm(kk)
    b4 = kk4 * heads_tm(a)

    def step(S, inp):
        r_t, d_t, k_t, v_t, kk_t, b_t = inp
        sa = jnp.einsum('bhvk,bhk->bhv', S, kk_t)
        S = S * d_t[:, :, None, :] - sa[..., None] * b_t[:, :, None, :] + v_t[..., None] * k_t[:, :, None, :]
        y = jnp.einsum('bhvk,bhk->bhv', S, r_t)
        return S, y

    S0 = jnp.zeros((B, H, N, N), jnp.float32)
    _, y = lax.scan(step, S0, (r4, d4, k4, v4, kk4, b4))
    y = y.transpose(1, 0, 2, 3)
    mean = jnp.mean(y, axis=-1, keepdims=True)
    var = jnp.mean(jnp.square(y - mean), axis=-1, keepdims=True)
    y = ((y - mean) * lax.rsqrt(var + GN_EPS)).reshape(B, T, D) * gn_w + gn_b
    bonus = jnp.sum(r.reshape(B, T, H, N) * k.reshape(B, T, H, N) * r_k, axis=-1, keepdims=True) * v.reshape(B, T, H, N)
    y = (y + bonus.reshape(B, T, D)) * jax.nn.silu(gp)
    return y.astype(h.dtype) @ w_out


def shared_kv(x, norm_kv, w_kv, k_norm, cos, sin):
    B, T, D = x.shape
    kv = rms_norm(x, norm_kv) @ w_kv
    k = kv[..., :WIDTH_B].reshape(B, T, N_HEADS_B, HEAD_DIM).transpose(0, 2, 1, 3)
    v = kv[..., WIDTH_B:].reshape(B, T, N_HEADS_B, HEAD_DIM).transpose(0, 2, 1, 3)
    k = partial_rope(rms_norm(k, k_norm), cos, sin)
    nb = -(-T // MOBA_BLOCK)
    pad = nb * MOBA_BLOCK - T
    k = jnp.pad(k, ((0, 0), (0, 0), (0, pad), (0, 0)))
    v = jnp.pad(v, ((0, 0), (0, 0), (0, pad), (0, 0)))
    kb = k.reshape(B, N_HEADS_B, nb, MOBA_BLOCK, HEAD_DIM)
    vb = v.reshape(B, N_HEADS_B, nb, MOBA_BLOCK, HEAD_DIM)
    kmean = jnp.mean(kb.astype(jnp.float32), axis=3)
    return kb, vb, kmean


def moba_attention(h, w_in, q_norm, w_out, kb, vb, kmean, cos, sin):
    B, T, D = h.shape
    H, hd, C, BS = N_HEADS_B, HEAD_DIM, QUERY_CHUNK, MOBA_BLOCK
    nb = kb.shape[2]
    topk = min(MOBA_TOPK, nb)
    scale = 1.0 / float(np.sqrt(hd))
    proj = h @ w_in
    q = proj[..., :WIDTH_B].reshape(B, T, H, hd).transpose(0, 2, 1, 3)
    gate = proj[..., WIDTH_B:]
    q = partial_rope(rms_norm(q, q_norm), cos, sin)
    nc = T // C
    qch = q.reshape(B, H, nc, C, hd).transpose(2, 0, 1, 3, 4)
    bi = jnp.arange(B)[:, None, None, None]
    hi = jnp.arange(H)[None, :, None, None]

    def chunk_fn(args):
        qc, ci = args
        cb = (ci * C) // BS
        qpos = ci * C + jnp.arange(C)
        gs = jnp.einsum('bhcd,bhnd->bhcn', qc.astype(jnp.float32), kmean)
        gs = jnp.where(jnp.arange(nb) < cb, gs, NEG)
        _, idx = lax.top_k(gs, topk)
        valid = idx < cb
        ksel = kb[bi, hi, idx]
        vsel = vb[bi, hi, idx]
        s_sel = jnp.einsum('bhcd,bhcjsd->bhcjs', qc, ksel).astype(jnp.float32) * scale
        s_sel = jnp.where(valid[..., None], s_sel, NEG).reshape(B, H, C, topk * BS)
        kown = lax.dynamic_index_in_dim(kb, cb, axis=2, keepdims=False)
        vown = lax.dynamic_index_in_dim(vb, cb, axis=2, keepdims=False)
        s_own = jnp.einsum('bhcd,bhsd->bhcs', qc, kown).astype(jnp.float32) * scale
        kpos = cb * BS + jnp.arange(BS)
        s_own = jnp.where(kpos[None, :] <= qpos[:, None], s_own, NEG)
        p = jax.nn.softmax(jnp.concatenate([s_sel, s_own], axis=-1), axis=-1)
        p_sel = p[..., :topk * BS].reshape(B, H, C, topk, BS).astype(vb.dtype)
        p_own = p[..., topk * BS:].astype(vb.dtype)
        return jnp.einsum('bhcjs,bhcjsd->bhcd', p_sel, vsel) + jnp.einsum('bhcs,bhsd->bhcd', p_own, vown)

    o = lax.map(chunk_fn, (qch, jnp.arange(nc)))
    o = o.transpose(1, 0, 3, 2, 4).reshape(B, T, WIDTH_B)
    return (o * jax.nn.silu(gate)) @ w_out


def setup_inputs(seed: int = 0) -> dict:
    key = jax.random.key(seed)
    ks = jax.random.split(key, 24)
    D, NA, NB_ = D_MODEL, N_A_LAYERS, N_B_LAYERS
    in_a = 4 * WIDTH_A + DECAY_LORA + ICLR_LORA
    nrm = jax.random.normal
    return {
        "x": nrm(ks[0], (BATCH, SEQ, D), jnp.float32),
        "norm_a": 1.0 + 0.02 * nrm(ks[1], (NA, D), jnp.float32),
        "mu_a": jax.random.uniform(ks[2], (NA, 6, D), jnp.float32),
        "w_in_a": nrm(ks[3], (NA, D, in_a), jnp.float32) * D ** -0.5,
        "w0_a": jax.random.uniform(ks[4], (NA, D), jnp.float32, -5.0, 0.0),
        "w2_a": nrm(ks[5], (NA, DECAY_LORA, D), jnp.float32) * 0.5 * DECAY_LORA ** -0.5,
        "a0_a": 0.1 * nrm(ks[6], (NA, D), jnp.float32),
        "a2_a": nrm(ks[7], (NA, ICLR_LORA, D), jnp.float32) * 0.5 * ICLR_LORA ** -0.5,
        "kk_a": 0.85 + 0.05 * nrm(ks[8], (NA, D), jnp.float32),
        "ka_a": 1.0 + 0.05 * nrm(ks[9], (NA, D), jnp.float32),
        "rk_a": 0.1 * nrm(ks[10], (NA, N_HEADS_A, HEAD_DIM), jnp.float32),
        "gn_w_a": 1.0 + 0.02 * nrm(ks[11], (NA, D), jnp.float32),
        "gn_b_a": 0.02 * nrm(ks[12], (NA, D), jnp.float32),
        "w_out_a": nrm(ks[13], (NA, WIDTH_A, D), jnp.float32) * WIDTH_A ** -0.5,
        "norm_kv": 1.0 + 0.02 * nrm(ks[14], (D,), jnp.float32),
        "w_kv": nrm(ks[15], (D, 2 * WIDTH_B), jnp.float32) * D ** -0.5,
        "k_norm": 1.0 + 0.02 * nrm(ks[16], (HEAD_DIM,), jnp.float32),
        "norm_b": 1.0 + 0.02 * nrm(ks[17], (NB_, D), jnp.float32),
        "w_in_b": nrm(ks[18], (NB_, D, 2 * WIDTH_B), jnp.float32) * D ** -0.5,
        "q_norm_b": 1.0 + 0.02 * nrm(ks[19], (NB_, HEAD_DIM), jnp.float32),
        "w_out_b": nrm(ks[20], (NB_, WIDTH_B, D), jnp.float32) * WIDTH_B ** -0.5,
    }


def reference(x, norm_a, mu_a, w_in_a, w0_a, w2_a, a0_a, a2_a, kk_a, ka_a, rk_a, gn_w_a, gn_b_a, w_out_a,
              norm_kv, w_kv, k_norm, norm_b, w_in_b, q_norm_b, w_out_b):
    T = x.shape[1]
    cos, sin = rope_tables(T)
    kb = vb = kmean = None
    for layer in range(DEPTH):
        if layer < N_A_LAYERS:
            i = layer
            x = x + rwkv7_time_mix(rms_norm(x, norm_a[i]), mu_a[i], w_in_a[i], w0_a[i], w2_a[i], a0_a[i], a2_a[i],
                                   kk_a[i], ka_a[i], rk_a[i], gn_w_a[i], gn_b_a[i], w_out_a[i])
        else:
            if layer == N_A_LAYERS:
                kb, vb, kmean = shared_kv(x, norm_kv, w_kv, k_norm, cos, sin)
            j = layer - N_A_LAYERS
            x = x + moba_attention(rms_norm(x, norm_b[j]), w_in_b[j], q_norm_b[j], w_out_b[j], kb, vb, kmean, cos, sin)
    return x
```

```cpp
#include <hip/hip_runtime.h>
#include <hip/hip_cooperative_groups.h>
#include <stdint.h>
#include <stdio.h>
namespace cg = cooperative_groups;

typedef __attribute__((ext_vector_type(8))) short bf16x8;
typedef __attribute__((ext_vector_type(16))) float f32x16;
typedef unsigned short bf16_t;
typedef __attribute__((ext_vector_type(4))) uint32_t u32x4;
typedef __bf16 bf16v2 __attribute__((ext_vector_type(2)));
typedef float f32x2 __attribute__((ext_vector_type(2)));
typedef float f32x4 __attribute__((ext_vector_type(4)));

#define T_ 8192
#define M_ 32768
#define NTHREADS 256
#define SMEM_BYTES 66560
#define MB_ ((size_t)1 << 20)
#define SLOT(i) ((size_t)(i) * 64 * MB_)
#define OFF_WT_IN_A  ((size_t)0)
#define OFF_WT_OUT_A (9 * MB_)
#define OFF_WT_KVQ   (11 * MB_)
#define OFF_WT_OUT_B (19 * MB_)
#define OFF_W2T      (21 * MB_)
#define OFF_A2T      (21 * MB_ + 131072)
#define OFF_ROPE     (21 * MB_ + 262144)
#define OFF_TWDN     (22 * MB_)
#define OFF_ADN      (26 * MB_)
#define OFF_SLOC     (30 * MB_)
#define OFF_P        (46 * MB_)
#define OFF_SC       (30 * MB_)
#define OFF_BAR      (63 * MB_)
#define OFF_WT_SMALL (62 * MB_)
#define OFF_KMEAN    (22 * MB_)
#define OFF_KPART    (40 * MB_)
#define OFF_SEL      (23 * MB_)
#define OFF_CNT      (25 * MB_)
#define OFF_ML       (26 * MB_)

#define NC_ 32
#define CL_ 256
#define TS_ 8
#define NARR_ 7

struct Params {
  const float* x; const float* norm_a; const float* mu_a; const float* w_in_a; const float* w0; const float* w2;
  const float* a0; const float* a2; const float* kk_a; const float* ka_a; const float* rk_a; const float* gn_w;
  const float* gn_b; const float* w_out_a; const float* norm_kv; const float* w_kv; const float* k_norm;
  const float* norm_b; const float* w_in_b; const float* q_norm; const float* w_out_b;
  float* out; unsigned char* ws;
};

__device__ __forceinline__ float bf2f(uint32_t u) { return __uint_as_float(u << 16); }
__device__ __forceinline__ uint32_t pack2(float a, float b) {
  f32x2 f = {a, b};
  bf16v2 r = __builtin_convertvector(f, bf16v2);
  return __builtin_bit_cast(uint32_t, r);
}
__device__ __forceinline__ uint32_t f2bf(float f) { return pack2(f, 0.f) & 0xffffu; }
__device__ __forceinline__ float lo_f(uint32_t u) { return __uint_as_float(u << 16); }
__device__ __forceinline__ float hi_f(uint32_t u) { return __uint_as_float(u & 0xffff0000u); }

template <int C>
__device__ __forceinline__ float dppf(float x) {
  return __int_as_float(__builtin_amdgcn_update_dpp(0, __float_as_int(x), C, 0xf, 0xf, true));
}
__device__ __forceinline__ float wave_sum(float x) {
  x += dppf<0xB1>(x);
  x += dppf<0x4E>(x);
  x += dppf<0x141>(x);
  x += dppf<0x140>(x);
  int xi = __float_as_int(x);
  float s = __int_as_float(__builtin_amdgcn_readlane(xi, 0)) + __int_as_float(__builtin_amdgcn_readlane(xi, 16)) +
            __int_as_float(__builtin_amdgcn_readlane(xi, 32)) + __int_as_float(__builtin_amdgcn_readlane(xi, 48));
  return s;
}
__device__ __forceinline__ float half_sum(float x) {
  x += __shfl_xor(x, 1);
  x += __shfl_xor(x, 2);
  x += __shfl_xor(x, 4);
  x += __shfl_xor(x, 8);
  x += __shfl_xor(x, 16);
  return x;
}
__device__ __forceinline__ int fresh_tid() {
  int t = threadIdx.x;
  asm volatile("" : "+v"(t));
  return t;
}
__device__ __forceinline__ float silu_f(float x) { return x / (1.0f + __expf(-x)); }

__device__ __forceinline__ uint32_t sw_off(int row, int c8) { return (uint32_t)(row * 128 + ((c8 ^ ((row >> 1) & 7)) << 4)); }

__device__ __forceinline__ void transpose_tile(const float* __restrict__ src, int lds, int k0, int n0s, bf16_t* dst, int ldd,
                                               int n0d, int kc0, const float* __restrict__ scale, int mode, float* tl) {
  const int tid = threadIdx.x;
  const int ty = tid >> 4, tx = tid & 15;
#pragma unroll
  for (int i = 0; i < 4; ++i) {
    int k = ty + 16 * i;
    float4 v = *(const float4*)(src + (size_t)(k0 + k) * lds + n0s + tx * 4);
    float sc = 1.0f;
    if (mode == 1) sc = scale[k0 + k];
    else if (mode == 2) sc = 1.0f - scale[k0 + k];
    tl[k * 65 + tx * 4 + 0] = v.x * sc;
    tl[k * 65 + tx * 4 + 1] = v.y * sc;
    tl[k * 65 + tx * 4 + 2] = v.z * sc;
    tl[k * 65 + tx * 4 + 3] = v.w * sc;
  }
  __syncthreads();
  const int nn = tid >> 2, kq = tid & 3;
  uint32_t o[8];
#pragma unroll
  for (int j = 0; j < 8; ++j) o[j] = pack2(tl[(kq * 16 + 2 * j) * 65 + nn], tl[(kq * 16 + 2 * j + 1) * 65 + nn]);
  uint4* dp = (uint4*)(dst + (size_t)(n0d + nn) * ldd + kc0 + k0 + kq * 16);
  dp[0] = make_uint4(o[0], o[1], o[2], o[3]);
  dp[1] = make_uint4(o[4], o[5], o[6], o[7]);
  __syncthreads();
}
__device__ __forceinline__ void transpose_job(const float* __restrict__ src, int N, int Kd, bf16_t* dst, const float* __restrict__ scale,
                                              int tile, float* tl) {
  const int ntn = N >> 6;
  const int kt = tile / ntn, nt = tile - kt * ntn;
  transpose_tile(src, N, kt * 64, nt * 64, dst, Kd, nt * 64, 0, scale, scale ? 1 : 0, tl);
}

__device__ __forceinline__ void norm_mix_rows(const Params& p) {
  unsigned char* ws = p.ws;
  bf16_t* dH = (bf16_t*)(ws + SLOT(1));
  bf16_t* dR = (bf16_t*)(ws + SLOT(6));
  bf16_t* dK = (bf16_t*)(ws + SLOT(7));
  bf16_t* dV = (bf16_t*)p.out;
  bf16_t* dG = (bf16_t*)((unsigned char*)p.out + 64 * MB_);
  const int lane = threadIdx.x & 63;
  const int wg = blockIdx.x * 4 + (threadIdx.x >> 6), nw = gridDim.x * 4;
  const int per = (M_ + nw - 1) / nw;
  const int r0 = wg * per;
  const int r1 = (r0 + per < M_) ? r0 + per : M_;
  if (r0 >= r1) return;
  float4 g4[4], m0[4], m2[4], m3[4], m5[4], hp[4];
#pragma unroll
  for (int i = 0; i < 4; ++i) {
    g4[i] = ((const float4*)p.norm_a)[lane + 64 * i];
    m0[i] = ((const float4*)(p.mu_a + 0 * 1024))[lane + 64 * i];
    m2[i] = ((const float4*)(p.mu_a + 2 * 1024))[lane + 64 * i];
    m3[i] = ((const float4*)(p.mu_a + 3 * 1024))[lane + 64 * i];
    m5[i] = ((const float4*)(p.mu_a + 5 * 1024))[lane + 64 * i];
    hp[i] = make_float4(0.f, 0.f, 0.f, 0.f);
  }
  const int rstart = ((r0 & (T_ - 1)) != 0) ? r0 - 1 : r0;
  float4 vn[4];
#pragma unroll
  for (int i = 0; i < 4; ++i) vn[i] = ((const float4*)(p.x + (size_t)rstart * 1024))[lane + 64 * i];
  for (int row = rstart; row < r1; ++row) {
    float4 v[4];
    float ss = 0.f;
#pragma unroll
    for (int i = 0; i < 4; ++i) v[i] = vn[i];
    if (row + 1 < r1) {
#pragma unroll
      for (int i = 0; i < 4; ++i) vn[i] = ((const float4*)(p.x + (size_t)(row + 1) * 1024))[lane + 64 * i];
    }
#pragma unroll
    for (int i = 0; i < 4; ++i) {
      ss += v[i].x * v[i].x + v[i].y * v[i].y + v[i].z * v[i].z + v[i].w * v[i].w;
    }
    ss = wave_sum(ss);
    const float rstd = rsqrtf(ss * (1.0f / 1024.0f) + 1e-6f);
    const bool emit = row >= r0;
    const bool first = (row & (T_ - 1)) == 0;
#pragma unroll
    for (int i = 0; i < 4; ++i) {
      float4 h = make_float4(v[i].x * rstd * g4[i].x, v[i].y * rstd * g4[i].y, v[i].z * rstd * g4[i].z, v[i].w * rstd * g4[i].w);
      float4 q = first ? make_float4(0.f, 0.f, 0.f, 0.f) : hp[i];
      hp[i] = h;
      if (emit) {
        const size_t o = (size_t)row * 1024 + (lane + 64 * i) * 4;
        const float dx = q.x - h.x, dy = q.y - h.y, dz = q.z - h.z, dw = q.w - h.w;
        *(uint2*)(dH + o) = make_uint2(pack2(h.x, h.y), pack2(h.z, h.w));
        *(uint2*)(dR + o) = make_uint2(pack2(h.x + dx * m0[i].x, h.y + dy * m0[i].y), pack2(h.z + dz * m0[i].z, h.w + dw * m0[i].w));
        *(uint2*)(dK + o) = make_uint2(pack2(h.x + dx * m2[i].x, h.y + dy * m2[i].y), pack2(h.z + dz * m2[i].z, h.w + dw * m2[i].w));
        *(uint2*)(dV + o) = make_uint2(pack2(h.x + dx * m3[i].x, h.y + dy * m3[i].y), pack2(h.z + dz * m3[i].z, h.w + dw * m3[i].w));
        *(uint2*)(dG + o) = make_uint2(pack2(h.x + dx * m5[i].x, h.y + dy * m5[i].y), pack2(h.z + dz * m5[i].z, h.w + dw * m5[i].w));
      }
    }
  }
}

__device__ __forceinline__ void rmsnorm_rows(const float* src, const float* __restrict__ g, bf16_t* dst) {
  const int lane = threadIdx.x & 63;
  const int wg = blockIdx.x * 4 + (threadIdx.x >> 6), nw = gridDim.x * 4;
  float4 vn[4];
  if (wg < M_) {
#pragma unroll
    for (int i = 0; i < 4; ++i) vn[i] = ((const float4*)(src + (size_t)wg * 1024))[lane + 64 * i];
  }
  for (int row = wg; row < M_; row += nw) {
    float4 v[4];
    float ss = 0.f;
#pragma unroll
    for (int i = 0; i < 4; ++i) v[i] = vn[i];
    if (row + nw < M_) {
#pragma unroll
      for (int i = 0; i < 4; ++i) vn[i] = ((const float4*)(src + (size_t)(row + nw) * 1024))[lane + 64 * i];
    }
#pragma unroll
    for (int i = 0; i < 4; ++i) {
      ss += v[i].x * v[i].x + v[i].y * v[i].y + v[i].z * v[i].z + v[i].w * v[i].w;
    }
    ss = wave_sum(ss);
    float rstd = rsqrtf(ss * (1.0f / 1024.0f) + 1e-6f);
#pragma unroll
    for (int i = 0; i < 4; ++i) {
      float4 gv = make_float4(1.f, 1.f, 1.f, 1.f);
      if (g) gv = ((const float4*)g)[lane + 64 * i];
      uint2 o;
      o.x = pack2(v[i].x * rstd * gv.x, v[i].y * rstd * gv.y);
      o.y = pack2(v[i].z * rstd * gv.z, v[i].w * rstd * gv.w);
      *(uint2*)(dst + (size_t)row * 1024 + (lane + 64 * i) * 4) = o;
    }
  }
}

__device__ __forceinline__ uint32_t mix2(uint32_t c, uint32_t pv, float m0_, float m1_) {
  float c0 = lo_f(c), c1 = hi_f(c), p0 = lo_f(pv), p1 = hi_f(pv);
  return pack2(c0 + (p0 - c0) * m0_, c1 + (p1 - c1) * m1_);
}

struct GemmTile { const bf16_t* A; const bf16_t* BT; int ldb; int NK; int m0; int brow0; };
struct GemmRegs { u32x4 ra[2][4], rb[2][4]; };
#define GEMM_SETUP(t_)                                                                          \
  const int tid = fresh_tid(), lane = tid & 63, w = tid >> 6;                                   \
  const int wr = w >> 1, wc = w & 1;                                                            \
  const int c8 = tid & 7, r32 = tid >> 3;                                                       \
  const int arow0 = (t_).m0 + r32;                                                              \
  const bf16_t* abase = (t_).A + (size_t)arow0 * 1024 + c8 * 8;                                 \
  const int ldb = (t_).ldb;                                                                     \
  const bf16_t* bbase = (t_).BT + (size_t)((t_).brow0 + r32) * ldb + c8 * 8;                    \
  const bool hp0 = (arow0 & (T_ - 1)) != 0;                                                     \
  (void)lane; (void)wr; (void)wc;
#define GLOAD(set_, kt_)                                                                        \
  {                                                                                             \
    const int kt__ = (kt_);                                                                     \
    const bool sh_ = (kt__ >= 16);                                                              \
    const bf16_t* ab_ = abase + (sh_ ? (kt__ - 16) * 64 - 1024 : kt__ * 64);                    \
    _Pragma("unroll") for (int p = 0; p < 4; ++p) {                                             \
      if (p == 0) {                                                                             \
        g.ra[set_][p] = (u32x4)(0u);                                                            \
        if (!sh_ || hp0) g.ra[set_][p] = *(const u32x4*)(ab_);                                  \
      } else g.ra[set_][p] = *(const u32x4*)(ab_ + (size_t)p * 32 * 1024);                      \
      g.rb[set_][p] = *(const u32x4*)(bbase + (size_t)p * 32 * ldb + kt__ * 64);                \
    }                                                                                           \
  }
#define LSTORE(set_, buf_)                                                                      \
  {                                                                                             \
    unsigned char* sA_ = smem + (buf_) * 32768;                                                 \
    unsigned char* sB_ = sA_ + 16384;                                                           \
    _Pragma("unroll") for (int p = 0; p < 4; ++p) {                                             \
      int row = r32 + 32 * p;                                                                   \
      *(u32x4*)(sA_ + sw_off(row, c8)) = g.ra[set_][p];                                         \
      *(u32x4*)(sB_ + sw_off(row, c8)) = g.rb[set_][p];                                         \
    }                                                                                           \
  }
#define KSTEP(buf_)                                                                             \
  {                                                                                             \
    const unsigned char* sA = smem + (buf_) * 32768;                                            \
    const unsigned char* sB = sA + 16384;                                                       \
    _Pragma("unroll") for (int ks = 0; ks < 4; ++ks) {                                          \
      bf16x8 a[2], b[2];                                                                        \
      const int ch = ks * 2 + (lane >> 5);                                                      \
      _Pragma("unroll") for (int i = 0; i < 2; ++i) {                                           \
        a[i] = *(const bf16x8*)(sA + sw_off(64 * wr + 32 * i + (lane & 31), ch));               \
        b[i] = *(const bf16x8*)(sB + sw_off(64 * wc + 32 * i + (lane & 31), ch));               \
      }                                                                                         \
      _Pragma("unroll") for (int i = 0; i < 2; ++i)                                             \
        _Pragma("unroll") for (int j = 0; j < 2; ++j)                                           \
          acc[i][j] = __builtin_amdgcn_mfma_f32_32x32x16_bf16(a[i], b[j], acc[i][j], 0, 0, 0);  \
    }                                                                                           \
  }
__device__ __forceinline__ void gemm_prefetch(const GemmTile& t, GemmRegs& g) {
  GEMM_SETUP(t)
  GLOAD(0, 0);
  GLOAD(1, 1);
}
__device__ __forceinline__ void gemm_main(const GemmTile& t, unsigned char* smem, GemmRegs& g, f32x16 (&acc)[2][2]) {
  GEMM_SETUP(t)
  const int NK = t.NK;
#pragma unroll
  for (int i = 0; i < 2; ++i)
#pragma unroll
    for (int j = 0; j < 2; ++j)
#pragma unroll
      for (int r = 0; r < 16; ++r) acc[i][j][r] = 0.f;
  LSTORE(0, 0);
  __syncthreads();
#pragma unroll 1
  for (int kt = 0; kt < NK; kt += 2) {
    if (kt + 2 < NK) GLOAD(0, kt + 2);
    KSTEP(0);
    LSTORE(1, 1);
    __syncthreads();
    if (kt + 3 < NK) GLOAD(1, kt + 3);
    KSTEP(1);
    if (kt + 2 < NK) LSTORE(0, 0);
    __syncthreads();
  }
}
#undef GLOAD
#undef LSTORE
#undef KSTEP

__device__ __forceinline__ void wave_tile_out(unsigned char* wl, const f32x16 (&acc)[2][2], bf16_t* dst, size_t ld, int lane) {
  const int c = lane & 31, hh = lane >> 5;
#pragma unroll
  for (int mi = 0; mi < 2; ++mi)
#pragma unroll
    for (int ni = 0; ni < 2; ++ni)
#pragma unroll
      for (int r = 0; r < 16; ++r) {
        const int rl = 32 * mi + (r & 3) + 8 * (r >> 2) + 4 * hh;
        *(bf16_t*)(wl + rl * 144 + (32 * ni + c) * 2) = (bf16_t)f2bf(acc[mi][ni][r]);
      }
  __builtin_amdgcn_wave_barrier();
#pragma unroll
  for (int i = 0; i < 8; ++i) {
    const int id = i * 64 + lane, row = id >> 3, ch = id & 7;
    uint4 v = *(const uint4*)(wl + row * 144 + ch * 16);
    *(uint4*)(dst + (size_t)row * ld + ch * 8) = v;
  }
  __builtin_amdgcn_wave_barrier();
}
__device__ __forceinline__ void wave_tile_out_t(unsigned char* wl, const f32x16 (&acc)[2][2], bf16_t* dst, size_t ld, int lane) {
  const int c = lane & 31, hh = lane >> 5;
#pragma unroll
  for (int mi = 0; mi < 2; ++mi)
#pragma unroll
    for (int ni = 0; ni < 2; ++ni)
#pragma unroll
      for (int g = 0; g < 4; ++g) {
        uint2 o;
        o.x = pack2(acc[mi][ni][4 * g + 0], acc[mi][ni][4 * g + 1]);
        o.y = pack2(acc[mi][ni][4 * g + 2], acc[mi][ni][4 * g + 3]);
        *(uint2*)(wl + (32 * ni + c) * 144 + (32 * mi + 8 * g + 4 * hh) * 2) = o;
      }
  __builtin_amdgcn_wave_barrier();
#pragma unroll
  for (int i = 0; i < 8; ++i) {
    const int id = i * 64 + lane, row = id >> 3, ch = id & 7;
    uint4 v = *(const uint4*)(wl + row * 144 + ch * 16);
    *(uint4*)(dst + (size_t)row * ld + ch * 8) = v;
  }
  __builtin_amdgcn_wave_barrier();
}

__device__ __forceinline__ bool xcd_tile(int l, int tn8, int& mt, int& nt) {
  const int xcd = blockIdx.x & 7;
  if (l >= 32 * tn8 * 8) return false;
  const int grp = l >> 6, r = l & 63;
  const int mg = grp / tn8, ng = grp - mg * tn8;
  mt = xcd * 32 + mg * 8 + (r & 7);
  nt = ng * 8 + (r >> 3);
  return true;
}

__device__ __forceinline__ void phase_gemm1(const Params& p, unsigned char* smem) {
  unsigned char* ws = p.ws;
  asm volatile("" : "+s"(ws));
  unsigned char* outb = (unsigned char*)p.out;
  asm volatile("" : "+s"(outb));
  const bf16_t* h0 = (const bf16_t*)(ws + SLOT(1));
  const bf16_t* aR = (const bf16_t*)(ws + SLOT(6));
  const bf16_t* aK = (const bf16_t*)(ws + SLOT(7));
  const bf16_t* aV = (const bf16_t*)outb;
  const bf16_t* aG = (const bf16_t*)(outb + 64 * MB_);
  const bf16_t* WT = (const bf16_t*)(ws + OFF_WT_IN_A);
  const bf16_t* WTS = (const bf16_t*)(ws + OFF_WT_SMALL);
  bf16_t* rbuf = (bf16_t*)(ws + SLOT(2));
  bf16_t* kbuf = (bf16_t*)(ws + SLOT(3));
  bf16_t* vbuf = (bf16_t*)(ws + SLOT(4));
  bf16_t* sgbuf = (bf16_t*)(ws + SLOT(5));
  bf16_t* twdn = (bf16_t*)(ws + OFF_TWDN);
  bf16_t* adn = (bf16_t*)(ws + OFF_ADN);
  const int tid_ = fresh_tid();
  const int lane = tid_ & 63, w = tid_ >> 6, wr = w >> 1, wc = w & 1;
  const int nloc = gridDim.x >> 3;
  const int nmain = (32 * 32 + nloc - 1) / nloc;
  auto find_tile = [&](int& it, int& mt, int& g, GemmTile& td) -> bool {
    for (; it < nmain + 1; ++it) {
      bool ok;
      if (it < nmain) ok = xcd_tile((blockIdx.x >> 3) + it * nloc, 4, mt, g);
      else { ok = (int)blockIdx.x < 256; mt = blockIdx.x; g = 32; }
      if (ok) {
        const int grp = g >> 3, gt = g & 7;
        td.A = grp == 0 ? aR : (grp == 1 ? aK : (grp == 2 ? aV : (grp == 3 ? aG : h0)));
        td.BT = grp == 4 ? WTS : WT;
        td.ldb = grp == 4 ? 2048 : 1024;
        td.NK = grp == 4 ? 32 : 16;
        td.m0 = mt * 128;
        td.brow0 = grp == 4 ? 0 : ((grp == 0 ? 0 : (grp == 1 ? 1088 : (grp == 2 ? 2112 : 3200))) + gt * 128);
        return true;
      }
    }
    return false;
  };
  GemmRegs gr;
  GemmTile cur, nxt;
  int it = 0, mt = 0, g = 0, itn = 0, mtn = 0, gn = 0;
  bool has = find_tile(it, mt, g, cur);
  if (has) gemm_prefetch(cur, gr);
  while (has) {
    f32x16 acc[2][2];
    const int grp = g >> 3, gt = g & 7;
    gemm_main(cur, smem, gr, acc);
    itn = it + 1;
    const bool hn = find_tile(itn, mtn, gn, nxt);
    if (hn) gemm_prefetch(nxt, gr);
    unsigned char* wl = smem + w * 9216;
    if (g < 32) {
      bf16_t* dst = grp == 0 ? rbuf : (grp == 1 ? kbuf : (grp == 2 ? vbuf : sgbuf));
      if (grp == 3) {
#pragma unroll
        for (int mi = 0; mi < 2; ++mi)
#pragma unroll
          for (int ni = 0; ni < 2; ++ni)
#pragma unroll
            for (int r = 0; r < 16; ++r) acc[mi][ni][r] = silu_f(acc[mi][ni][r]);
      }
      wave_tile_out(wl, acc, dst + (size_t)(mt * 128 + 64 * wr) * 1024 + gt * 128 + 64 * wc, 1024, lane);
    } else {
      if (wc == 0) {
#pragma unroll
        for (int mi = 0; mi < 2; ++mi)
#pragma unroll
          for (int ni = 0; ni < 2; ++ni)
#pragma unroll
            for (int r = 0; r < 16; ++r) acc[mi][ni][r] = tanhf(acc[mi][ni][r]);
      }
      wave_tile_out(wl, acc, (wc == 0 ? twdn : adn) + (size_t)(mt * 128 + 64 * wr) * 64, 64, lane);
    }
    __syncthreads();
    cur = nxt; it = itn; mt = mtn; g = gn; has = hn;
  }
}

__device__ __forceinline__ void phase_gemm_res(const bf16_t* A, const bf16_t* WT, const float* res, float* out, unsigned char* smem) {
  asm volatile("" : "+s"(A), "+s"(WT));
  const int tid_ = fresh_tid();
  const int lane = tid_ & 63, w = tid_ >> 6, wr = w >> 1, wc = w & 1;
  const int nloc = gridDim.x >> 3;
  GemmRegs gr;
  GemmTile cur, nxt;
  int l = blockIdx.x >> 3, mt = 0, nt = 0, mtn = 0, ntn = 0;
  bool has = xcd_tile(l, 1, mt, nt);
  if (has) { cur = GemmTile{A, WT, 1024, 16, mt * 128, nt * 128}; gemm_prefetch(cur, gr); }
  while (has) {
    f32x16 acc[2][2];
    gemm_main(cur, smem, gr, acc);
    l += nloc;
    const bool hn = xcd_tile(l, 1, mtn, ntn);
    if (hn) { nxt = GemmTile{A, WT, 1024, 16, mtn * 128, ntn * 128}; gemm_prefetch(nxt, gr); }
#pragma unroll
    for (int mi = 0; mi < 2; ++mi) {
      float rv[2][16];
#pragma unroll
      for (int ni = 0; ni < 2; ++ni)
#pragma unroll
        for (int r = 0; r < 16; ++r) {
          int row = mt * 128 + 64 * wr + 32 * mi + (r & 3) + 8 * (r >> 2) + 4 * (lane >> 5);
          int col = nt * 128 + 64 * wc + 32 * ni + (lane & 31);
          rv[ni][r] = res[(size_t)row * 1024 + col];
        }
#pragma unroll
      for (int ni = 0; ni < 2; ++ni)
#pragma unroll
        for (int r = 0; r < 16; ++r) {
          int row = mt * 128 + 64 * wr + 32 * mi + (r & 3) + 8 * (r >> 2) + 4 * (lane >> 5);
          int col = nt * 128 + 64 * wc + 32 * ni + (lane & 31);
          out[(size_t)row * 1024 + col] = rv[ni][r] + acc[mi][ni][r];
        }
    }
    cur = nxt; mt = mtn; nt = ntn; has = hn;
  }
}

__device__ __forceinline__ void phase_gemm_kvq(const Params& p, unsigned char* smem) {
  unsigned char* ws = p.ws;
  asm volatile("" : "+s"(ws));
  const bf16_t* h1 = (const bf16_t*)(ws + SLOT(1));
  const bf16_t* WT = (const bf16_t*)(ws + OFF_WT_KVQ);
  bf16_t* Kb = (bf16_t*)(ws + SLOT(3));
  bf16_t* Vt = (bf16_t*)(ws + SLOT(4));
  bf16_t* Qb = (bf16_t*)(ws + SLOT(5));
  bf16_t* sgb = (bf16_t*)(ws + SLOT(6));
  const float2* rope = (const float2*)(ws + OFF_ROPE);
  const int tid_ = fresh_tid();
  const int lane = tid_ & 63, w = tid_ >> 6, wr = w >> 1, wc = w & 1;
  const int c = lane & 31, hh = lane >> 5;
  const int nloc = gridDim.x >> 3;
  GemmRegs gr;
  GemmTile cur, nxt;
  int l = blockIdx.x >> 3, mt = 0, nt = 0, mtn = 0, ntn = 0;
  bool has = xcd_tile(l, 4, mt, nt);
  if (has) { cur = GemmTile{h1, WT, 1024, 16, mt * 128, nt * 128}; gemm_prefetch(cur, gr); }
  while (has) {
    const int type = nt >> 3;
    const int head = (nt & 7) * 2 + wc;
    f32x16 acc[2][2];
    gemm_main(cur, smem, gr, acc);
    l += nloc;
    const bool hn = xcd_tile(l, 4, mtn, ntn);
    if (hn) { nxt = GemmTile{h1, WT, 1024, 16, mtn * 128, ntn * 128}; gemm_prefetch(nxt, gr); }
    const int rowbase = mt * 128 + 64 * wr;
    const int b = rowbase >> 13;
    const int t0 = rowbase & (T_ - 1);
    unsigned char* wl = smem + w * 9216;
    if (type == 0 || type == 2) {
      const float* wn = (type == 0) ? p.k_norm : p.q_norm;
      const float osc = (type == 2) ? 0.18033688011112042f : 1.0f;
      const float wn0 = wn[c] * osc, wn1 = wn[32 + c] * osc;
      bf16_t* dst = (type == 0) ? Kb : Qb;
      {
        float2* rl = (float2*)wl;
        float2 rv[8];
#pragma unroll
        for (int j = 0; j < 8; ++j) rv[j] = rope[(size_t)t0 * 8 + lane + 64 * j];
#pragma unroll
        for (int j = 0; j < 8; ++j) rl[lane + 64 * j] = rv[j];
        __builtin_amdgcn_wave_barrier();
      }
#pragma unroll
      for (int mi = 0; mi < 2; ++mi)
#pragma unroll
        for (int r = 0; r < 16; ++r) {
          float v0 = acc[mi][0][r], v1 = acc[mi][1][r];
          float ss = v0 * v0 + v1 * v1;
          ss += dppf<0xB1>(ss);
          ss += dppf<0x4E>(ss);
          ss += dppf<0x141>(ss);
          ss += dppf<0x140>(ss);
          ss += __shfl_xor(ss, 16);
          float rstd = rsqrtf(ss * (1.0f / 64.0f) + 1e-6f);
          v0 = v0 * rstd * wn0;
          v1 = v1 * rstd * wn1;
          const int tl_ = 32 * mi + (r & 3) + 8 * (r >> 2) + 4 * hh;
          float partner = dppf<0x128>(v0);
          {
            float2 cs = ((const float2*)wl)[tl_ * 8 + (c & 7)];
            float rot = (c < 8) ? (v0 * cs.x - partner * cs.y) : (v0 * cs.x + partner * cs.y);
            v0 = (c < 16) ? rot : v0;
          }
          acc[mi][0][r] = v0;
          acc[mi][1][r] = v1;
        }
      if (type == 0) {
        float* kpart = (float*)(ws + OFF_KPART);
#pragma unroll
        for (int ni = 0; ni < 2; ++ni) {
          float cs = 0.f;
#pragma unroll
          for (int mi = 0; mi < 2; ++mi)
#pragma unroll
            for (int r = 0; r < 16; ++r) cs += acc[mi][ni][r];
          cs += __shfl_xor(cs, 32);
          if (hh == 0) kpart[((size_t)((b * 16 + head) * 32 + (t0 >> 8)) * 4 + ((t0 >> 6) & 3)) * 64 + 32 * ni + c] = cs;
        }
      }
      __builtin_amdgcn_wave_barrier();
      wave_tile_out(wl, acc, dst + ((size_t)(b * 16 + head) * T_ + t0) * 64, 64, lane);
    } else if (type == 1) {
      wave_tile_out_t(wl, acc, Vt + (size_t)(b * 16 + head) * 64 * T_ + t0, T_, lane);
    } else {
#pragma unroll
      for (int mi = 0; mi < 2; ++mi)
#pragma unroll
        for (int ni = 0; ni < 2; ++ni)
#pragma unroll
          for (int r = 0; r < 16; ++r) acc[mi][ni][r] = silu_f(acc[mi][ni][r]);
      wave_tile_out(wl, acc, sgb + (size_t)rowbase * 1024 + (nt & 7) * 128 + 64 * wc, 1024, lane);
    }
    __syncthreads();
    cur = nxt; mt = mtn; nt = ntn; has = hn;
  }
}

__device__ __forceinline__ void phase_prep2(const Params& p) {
  unsigned char* ws = p.ws;
  const bf16_t* twdn = (const bf16_t*)(ws + OFF_TWDN);
  const bf16_t* adn = (const bf16_t*)(ws + OFF_ADN);
  const bf16_t* W2T = (const bf16_t*)(ws + OFF_W2T);
  const bf16_t* A2T = (const bf16_t*)(ws + OFF_A2T);
  bf16_t* kbuf = (bf16_t*)(ws + SLOT(3));
  bf16_t* kkbuf = (bf16_t*)(ws + SLOT(1));
  bf16_t* bbuf = (bf16_t*)(ws + SLOT(6));
  bf16_t* rbuf = (bf16_t*)(ws + SLOT(2));
  bf16_t* ebuf = (bf16_t*)p.out;
  float2* scb = (float2*)(ws + OFF_SC);
  const int tid_ = fresh_tid();
  const int lane = tid_ & 63, w = tid_ >> 6;
  const int c = lane & 31, hh = lane >> 5;
  for (int id = blockIdx.x; id < 256 * 16; id += gridDim.x) {
    const int mt = id >> 4, h = id & 15;
    const int row0 = mt * 128 + 32 * w;
    f32x16 aw[2], aa[2];
#pragma unroll
    for (int i = 0; i < 2; ++i)
#pragma unroll
      for (int r = 0; r < 16; ++r) { aw[i][r] = 0.f; aa[i][r] = 0.f; }
#pragma unroll
    for (int ks = 0; ks < 4; ++ks) {
      const int ko = ks * 16 + 8 * hh;
      bf16x8 fw = *(const bf16x8*)(twdn + (size_t)(row0 + c) * 64 + ko);
      bf16x8 fa = *(const bf16x8*)(adn + (size_t)(row0 + c) * 64 + ko);
#pragma unroll
      for (int ni = 0; ni < 2; ++ni) {
        const int n = h * 64 + 32 * ni + c;
        bf16x8 bw = *(const bf16x8*)(W2T + (size_t)n * 64 + ko);
        bf16x8 ba = *(const bf16x8*)(A2T + (size_t)n * 64 + ko);
        aw[ni] = __builtin_amdgcn_mfma_f32_32x32x16_bf16(fw, bw, aw[ni], 0, 0, 0);
        aa[ni] = __builtin_amdgcn_mfma_f32_32x32x16_bf16(fa, ba, aa[ni], 0, 0, 0);
      }
    }
    float w0c[2], a0c[2], kkc[2], kac[2], rkc[2];
#pragma unroll
    for (int ni = 0; ni < 2; ++ni) {
      const int col = h * 64 + 32 * ni + c;
      w0c[ni] = p.w0[col]; a0c[ni] = p.a0[col]; kkc[ni] = p.kk_a[col]; kac[ni] = p.ka_a[col]; rkc[ni] = p.rk_a[col];
    }
#pragma unroll
    for (int rh = 0; rh < 2; ++rh) {
    uint32_t kraw[8][2], rraw[8][2];
#pragma unroll
    for (int r8 = 0; r8 < 8; ++r8) {
      const int r = rh * 8 + r8;
      const int row = row0 + (r & 3) + 8 * (r >> 2) + 4 * hh;
#pragma unroll
      for (int ni = 0; ni < 2; ++ni) {
        const size_t o = (size_t)row * 1024 + h * 64 + 32 * ni + c;
        kraw[r8][ni] = kbuf[o];
        rraw[r8][ni] = rbuf[o];
      }
    }
#pragma unroll
    for (int r8 = 0; r8 < 8; ++r8) {
      const int r = rh * 8 + r8;
      const int row = row0 + (r & 3) + 8 * (r >> 2) + 4 * hh;
      float kr[2], kv[2], rr[2];
#pragma unroll
      for (int ni = 0; ni < 2; ++ni) {
        kr[ni] = bf2f(kraw[r8][ni]);
        rr[ni] = bf2f(rraw[r8][ni]);
        kv[ni] = kr[ni] * kkc[ni];
      }
      float ss = half_sum(kv[0] * kv[0] + kv[1] * kv[1]);
      float inv = 1.0f / fmaxf(sqrtf(ss), 1e-12f);
      float decv[2], kkr[2];
      float pbr = 0.f, pc1 = 0.f, pc2 = 0.f;
#pragma unroll
      for (int ni = 0; ni < 2; ++ni) {
        const size_t o = (size_t)row * 1024 + h * 64 + 32 * ni + c;
        float z = w0c[ni] + aw[ni][r];
        float u = -z;
        float sp = fmaxf(u, 0.f) + log1pf(expf(-fabsf(u)));
        float wl = -sp - 0.5f;
        float e = expf(wl);
        float a = 1.0f / (1.0f + expf(-(a0c[ni] + aa[ni][r])));
        float kkn = kv[ni] * inv;
        float k2 = kr[ni] * (1.0f + (a - 1.0f) * kac[ni]);
        const uint32_t ue = f2bf(e), uk2 = f2bf(k2), ukk = f2bf(kkn), ub = f2bf(kkn * a);
        ebuf[o] = (bf16_t)ue;
        kbuf[o] = (bf16_t)uk2;
        kkbuf[o] = (bf16_t)ukk;
        bbuf[o] = (bf16_t)ub;
        const float k2r = bf2f(uk2), br_ = bf2f(ub);
        pbr = fmaf(br_, rr[ni], pbr);
        pc1 = fmaf(k2r, rr[ni], pc1);
        pc2 = fmaf(rr[ni] * k2r, rkc[ni], pc2);
        decv[ni] = expf(-bf2f(ue));
        kkr[ni] = bf2f(ukk);
      }
      pbr = half_sum(pbr); pc1 = half_sum(pc1); pc2 = half_sum(pc2);
#pragma unroll
      for (int ni = 0; ni < 2; ++ni) {
        const size_t o = (size_t)row * 1024 + h * 64 + 32 * ni + c;
        rbuf[o] = (bf16_t)f2bf(decv[ni] * rr[ni] - kkr[ni] * pbr);
      }
      if (c == 0) scb[(size_t)row * 16 + h] = make_float2(pc1, pc2);
    }
    }
  }
}

#define SCAN_SLOC(p) ((float*)((unsigned char*)(p).out + 64 * MB_))
#define SCAN_P(p) ((float*)((unsigned char*)(p).out + 96 * MB_))

__device__ __forceinline__ void phase_scan2(const Params& p, unsigned char* smem) {
  float* Pl = (float*)smem;
  float* St = Pl + 64 * 64;
  float* Sloc = SCAN_SLOC(p);
  const float* Pm = SCAN_P(p);
  const int tid = threadIdx.x;
  const int vl = tid >> 4, kq = tid & 15;
  if (gridDim.x >= 512 && blockIdx.x >= 256) {
    float* tl = (float*)smem;
    unsigned char* ws = p.ws;
    for (int j = 1056 + ((int)blockIdx.x - 256); j < 2592; j += (int)gridDim.x - 256) {
      if (j < 1312) transpose_job(p.w_out_a, 1024, 1024, (bf16_t*)(ws + OFF_WT_OUT_A), nullptr, j - 1056, tl);
      else if (j < 1824) transpose_job(p.w_kv, 2048, 1024, (bf16_t*)(ws + OFF_WT_KVQ), p.norm_kv, j - 1312, tl);
      else if (j < 2336) transpose_job(p.w_in_b, 2048, 1024, (bf16_t*)(ws + OFF_WT_KVQ) + (size_t)2048 * 1024, p.norm_b, j - 1824, tl);
      else transpose_job(p.w_out_b, 1024, 1024, (bf16_t*)(ws + OFF_WT_OUT_B), nullptr, j - 2336, tl);
    }
  }
  for (int unit = blockIdx.x; unit < 256; unit += gridDim.x) {
    const int bh = unit >> 2, rg4 = unit & 3;
    const int v = rg4 * 16 + vl;
    __syncthreads();
    *(f32x4*)(St + vl * 68 + 4 * kq) = (f32x4){0.f, 0.f, 0.f, 0.f};
    f32x4 pn[4], sn;
    {
      const f32x4* Pg = (const f32x4*)(Pm + (size_t)(bh * NC_) * 4096);
#pragma unroll
      for (int i = 0; i < 4; ++i) pn[i] = Pg[tid + 256 * i];
      sn = *(const f32x4*)(Sloc + (size_t)(bh * NC_) * 4096 + v * 64 + 4 * kq);
    }
    for (int cidx = 0; cidx < NC_ - 1; ++cidx) {
      __syncthreads();
#pragma unroll
      for (int i = 0; i < 4; ++i) ((f32x4*)Pl)[tid + 256 * i] = pn[i];
      f32x4 acc = sn;
      float* Sg = Sloc + (size_t)(bh * NC_ + cidx) * 4096 + v * 64 + 4 * kq;
      if (cidx + 1 < NC_ - 1) {
        const f32x4* Pg = (const f32x4*)(Pm + (size_t)(bh * NC_ + cidx + 1) * 4096);
#pragma unroll
        for (int i = 0; i < 4; ++i) pn[i] = Pg[tid + 256 * i];
        sn = *(const f32x4*)(Sg + 4096);
      }
      __syncthreads();
      f32x4 a0 = acc, a1 = (f32x4){0.f, 0.f, 0.f, 0.f};
#pragma unroll 8
      for (int j = 0; j < 64; j += 2) {
        const float s0 = St[vl * 68 + j], s1 = St[vl * 68 + j + 1];
        const f32x4 p0 = *(const f32x4*)(Pl + j * 64 + 4 * kq);
        const f32x4 p1 = *(const f32x4*)(Pl + (j + 1) * 64 + 4 * kq);
        a0 = p0 * s0 + a0;
        a1 = p1 * s1 + a1;
      }
      acc = a0 + a1;
      __syncthreads();
      *(f32x4*)(St + vl * 68 + 4 * kq) = acc;
      *(f32x4*)Sg = acc;
    }
  }
}

#define M3_WAVE_BYTES 16640
#define M3_XT 0
#define M3_W 4096
#define M3_WT 8192
#define M3_Z 12288
#define M3_G 16384
template <int T>
__device__ __forceinline__ void m3_recur(const float* zt, const float (&D)[32], const float (&vs)[16], float (&sav)[16], float (&yv)[16]) {
  float sa = D[T], y = D[16 + T];
  if constexpr (T > 0) {
    constexpr int NQ = (T + 3) / 4;
#pragma unroll
    for (int q = 0; q < NQ; ++q) {
      const f32x4 a4 = *(const f32x4*)(zt + T * 32 + 4 * q);
      const f32x4 b4 = *(const f32x4*)(zt + T * 32 + 16 + 4 * q);
      const f32x4 c4 = *(const f32x4*)(zt + (16 + T) * 32 + 4 * q);
      const f32x4 e4 = *(const f32x4*)(zt + (16 + T) * 32 + 16 + 4 * q);
#pragma unroll
      for (int i = 0; i < 4; ++i) {
        const int s_ = 4 * q + i;
        if (s_ < T) {
          sa = fmaf(vs[s_], a4[i], sa); sa = fmaf(-sav[s_], b4[i], sa);
          y = fmaf(vs[s_], c4[i], y); y = fmaf(-sav[s_], e4[i], y);
        }
      }
    }
  }
  sav[T] = sa;
  yv[T] = y;
  if constexpr (T + 1 < 16) m3_recur<T + 1>(zt, D, vs, sav, yv);
}

__device__ __forceinline__ void phase_scan3_mfma(const Params& p, unsigned char* smem) {
  const int lane = threadIdx.x & 63, w = __builtin_amdgcn_readfirstlane(threadIdx.x >> 6);
  const int c = lane & 31, hh = lane >> 5;
  unsigned char* wl = smem + w * M3_WAVE_BYTES;
  unsigned char* ws = p.ws;
  const float* Sst = SCAN_SLOC(p);
  const bf16_t* kkb = (const bf16_t*)(ws + SLOT(1));
  const bf16_t* rb = (const bf16_t*)(ws + SLOT(2));
  const bf16_t* kb = (const bf16_t*)(ws + SLOT(3));
  const bf16_t* vb = (const bf16_t*)(ws + SLOT(4));
  const bf16_t* sgb = (const bf16_t*)(ws + SLOT(5));
  const bf16_t* bb = (const bf16_t*)(ws + SLOT(6));
  const bf16_t* eb = (const bf16_t*)p.out;
  const float2* scb = (const float2*)(ws + OFF_SC);
  bf16_t* yg = (bf16_t*)(ws + SLOT(7));
  const int wg = blockIdx.x * 4 + w, nw = gridDim.x * 4;
  for (int unit = wg; unit < 64 * NC_; unit += nw) {
    const int bh = unit / NC_, cidx = unit - bh * NC_;
    const int b = bh >> 4, h = bh & 15;
    f32x16 H[2][2];
#pragma unroll
    for (int kt = 0; kt < 2; ++kt)
#pragma unroll
      for (int vt = 0; vt < 2; ++vt) {
#pragma unroll
        for (int g = 0; g < 4; ++g) {
          f32x4 t = {0.f, 0.f, 0.f, 0.f};
          if (cidx != 0) t = *(const f32x4*)(Sst + ((size_t)(bh * NC_ + cidx - 1) * 64 + (c + 32 * vt)) * 64 + 32 * kt + 8 * g + 4 * hh);
          H[kt][vt][4 * g + 0] = t.x; H[kt][vt][4 * g + 1] = t.y; H[kt][vt][4 * g + 2] = t.z; H[kt][vt][4 * g + 3] = t.w;
        }
      }
    const float gw = p.gn_w[h * 64 + lane], gb = p.gn_b[h * 64 + lane];
    const int row0 = b * T_ + cidx * CL_;
    const size_t base = (size_t)row0 * 1024 + h * 64 + lane;
#pragma unroll 1
    for (int stg = 0; stg < CL_ / 16; ++stg) {
      const int step0 = stg * 16;
      float G = 1.0f;
      uint32_t kbits[16], bbits[16];
      uint32_t rkk[16], re[16], rbv[16], rkv[16], rrv[16], rvv[16], rsg[16];
#pragma unroll
      for (int i = 0; i < 16; ++i) {
        const size_t o = base + (size_t)(step0 + i) * 1024;
        rkk[i] = kkb[o]; re[i] = eb[o]; rbv[i] = bb[o]; rkv[i] = kb[o]; rrv[i] = rb[o]; rvv[i] = vb[o]; rsg[i] = sgb[o];
      }
      const float2 cc = scb[(size_t)(row0 + step0 + (lane & 15)) * 16 + h];
#pragma unroll
      for (int s_ = 0; s_ < 16; ++s_) {
        const float kkt = bf2f(rkk[s_]) * G, rt = bf2f(rrv[s_]) * G;
        G *= __expf(-bf2f(re[s_]));
        const float iG = __builtin_amdgcn_rcpf(G);
        kbits[s_] = f2bf(bf2f(rkv[s_]) * iG);
        bbits[s_] = f2bf(bf2f(rbv[s_]) * iG);
        const int co = (lane & 7) * 2, ch = lane >> 3;
        *(bf16_t*)(wl + M3_XT + sw_off(s_, ch) + co) = (bf16_t)f2bf(kkt);
        *(bf16_t*)(wl + M3_XT + sw_off(16 + s_, ch) + co) = (bf16_t)f2bf(rt);
        *(bf16_t*)(wl + M3_W + sw_off(s_, ch) + co) = (bf16_t)kbits[s_];
        *(bf16_t*)(wl + M3_W + sw_off(16 + s_, ch) + co) = (bf16_t)bbits[s_];
      }
      {
        uint4* wr_ = (uint4*)(wl + M3_WT + lane * 64);
        wr_[0] = make_uint4(kbits[0] | (kbits[1] << 16), kbits[2] | (kbits[3] << 16), kbits[4] | (kbits[5] << 16), kbits[6] | (kbits[7] << 16));
        wr_[1] = make_uint4(kbits[8] | (kbits[9] << 16), kbits[10] | (kbits[11] << 16), kbits[12] | (kbits[13] << 16), kbits[14] | (kbits[15] << 16));
        wr_[2] = make_uint4(bbits[0] | (bbits[1] << 16), bbits[2] | (bbits[3] << 16), bbits[4] | (bbits[5] << 16), bbits[6] | (bbits[7] << 16));
        wr_[3] = make_uint4(bbits[8] | (bbits[9] << 16), bbits[10] | (bbits[11] << 16), bbits[12] | (bbits[13] << 16), bbits[14] | (bbits[15] << 16));
        ((float*)(wl + M3_G))[lane] = G;
      }
      float vs[16], sgs[16];
#pragma unroll
      for (int i = 0; i < 16; ++i) {
        vs[i] = bf2f(rvv[i]);
        sgs[i] = bf2f(rsg[i]);
      }
      __builtin_amdgcn_wave_barrier();
      {
        f32x16 z;
#pragma unroll
        for (int r = 0; r < 16; ++r) z[r] = 0.f;
#pragma unroll
        for (int ks = 0; ks < 4; ++ks) {
          const bf16x8 a = *(const bf16x8*)(wl + M3_W + sw_off(c, 2 * ks + hh));
          const bf16x8 bq = *(const bf16x8*)(wl + M3_XT + sw_off(c, 2 * ks + hh));
          z = __builtin_amdgcn_mfma_f32_32x32x16_bf16(a, bq, z, 0, 0, 0);
        }
        float* zt = (float*)(wl + M3_Z);
#pragma unroll
        for (int g = 0; g < 4; ++g)
          *(f32x4*)(zt + c * 32 + 8 * g + 4 * hh) = (f32x4){z[4 * g], z[4 * g + 1], z[4 * g + 2], z[4 * g + 3]};
      }
      f32x16 DT[2];
#pragma unroll
      for (int vt = 0; vt < 2; ++vt) {
#pragma unroll
        for (int r = 0; r < 16; ++r) DT[vt][r] = 0.f;
#pragma unroll
        for (int kt = 0; kt < 2; ++kt)
#pragma unroll
          for (int sp = 0; sp < 2; ++sp) {
            union { uint32_t u[4]; bf16x8 v; } hb;
#pragma unroll
            for (int jj = 0; jj < 4; ++jj) hb.u[jj] = pack2(H[kt][vt][8 * sp + 2 * jj], H[kt][vt][8 * sp + 2 * jj + 1]);
            union { uint2 u[2]; bf16x8 v; } xa;
            xa.u[0] = *(const uint2*)(wl + M3_XT + sw_off(c, 4 * kt + 2 * sp) + 8 * hh);
            xa.u[1] = *(const uint2*)(wl + M3_XT + sw_off(c, 4 * kt + 2 * sp + 1) + 8 * hh);
            DT[vt] = __builtin_amdgcn_mfma_f32_32x32x16_bf16(xa.v, hb.v, DT[vt], 0, 0, 0);
          }
      }
      float D[32];
      {
        float own[16], rcv[16];
#pragma unroll
        for (int r = 0; r < 16; ++r) {
          own[r] = hh ? DT[1][r] : DT[0][r];
          const float snd = hh ? DT[0][r] : DT[1][r];
          rcv[r] = __shfl_xor(snd, 32);
        }
#pragma unroll
        for (int t = 0; t < 32; ++t) {
          const int r = (t & 3) + 4 * (t >> 3);
          const int hs = (t >> 2) & 1;
          D[t] = (hs == hh) ? own[r] : rcv[r];
        }
      }
      float sav[16], yv[16];
      __builtin_amdgcn_wave_barrier();
      m3_recur<0>((const float*)(wl + M3_Z), D, vs, sav, yv);
      {
        float* yb = (float*)(wl + M3_XT);
        float* stt = (float*)(wl + M3_Z);
        float yt[16];
#pragma unroll
        for (int t = 0; t < 16; ++t) {
          const float c1 = __int_as_float(__builtin_amdgcn_readlane(__float_as_int(cc.x), t));
          yt[t] = yv[t] + vs[t] * c1;
          yb[t * 64 + lane] = yt[t];
        }
        __builtin_amdgcn_wave_barrier();
        {
          const int tt = lane >> 2, q4 = lane & 3;
          float a1 = 0.f, a2 = 0.f;
#pragma unroll
          for (int i = 0; i < 4; ++i) {
            const f32x4 y4 = *(const f32x4*)(yb + tt * 64 + q4 * 16 + 4 * i);
            a1 += (y4.x + y4.y) + (y4.z + y4.w);
            a2 += (y4.x * y4.x + y4.y * y4.y) + (y4.z * y4.z + y4.w * y4.w);
          }
          a1 += dppf<0xB1>(a1); a1 += dppf<0x4E>(a1);
          a2 += dppf<0xB1>(a2); a2 += dppf<0x4E>(a2);
          if (q4 == 0) *(float2*)(stt + 2 * tt) = make_float2(a1 * (1.0f / 64.0f), a2 * (1.0f / 64.0f));
        }
        __builtin_amdgcn_wave_barrier();
#pragma unroll
        for (int t = 0; t < 16; ++t) {
          const float2 ms = *(const float2*)(stt + 2 * t);
          const float c2 = __int_as_float(__builtin_amdgcn_readlane(__float_as_int(cc.y), t));
          const float var = fmaxf(ms.y - ms.x * ms.x, 0.f);
          const float yn = (yt[t] - ms.x) * rsqrtf(var + 64e-5f) * gw + gb;
          const float o = (yn + c2 * vs[t]) * sgs[t];
          yg[base + (size_t)(step0 + t) * 1024] = (bf16_t)f2bf(o);
        }
      }
      {
        float ownv[8], owns[8], rcvv[8], rcvs[8];
#pragma unroll
        for (int jj = 0; jj < 8; ++jj) {
          ownv[jj] = hh ? vs[8 + jj] : vs[jj];
          owns[jj] = hh ? sav[8 + jj] : sav[jj];
          const float sv = hh ? vs[jj] : vs[8 + jj];
          const float ss = hh ? sav[jj] : sav[8 + jj];
          rcvv[jj] = __shfl_xor(sv, 32);
          rcvs[jj] = __shfl_xor(ss, 32);
        }
#pragma unroll
        for (int vt = 0; vt < 2; ++vt) {
          union { uint32_t u[4]; bf16x8 v; } bv, bs;
#pragma unroll
          for (int q = 0; q < 4; ++q) {
            const float v0 = (hh == vt) ? ownv[2 * q] : rcvv[2 * q], v1 = (hh == vt) ? ownv[2 * q + 1] : rcvv[2 * q + 1];
            const float s0 = (hh == vt) ? owns[2 * q] : rcvs[2 * q], s1_ = (hh == vt) ? owns[2 * q + 1] : rcvs[2 * q + 1];
            bv.u[q] = pack2(v0, v1);
            bs.u[q] = pack2(-s0, -s1_);
          }
#pragma unroll
          for (int kt = 0; kt < 2; ++kt) {
            const bf16x8 a0 = *(const bf16x8*)(wl + M3_WT + (c + 32 * kt) * 64 + 16 * hh);
            const bf16x8 a1 = *(const bf16x8*)(wl + M3_WT + (c + 32 * kt) * 64 + 32 + 16 * hh);
            H[kt][vt] = __builtin_amdgcn_mfma_f32_32x32x16_bf16(a0, bv.v, H[kt][vt], 0, 0, 0);
            H[kt][vt] = __builtin_amdgcn_mfma_f32_32x32x16_bf16(a1, bs.v, H[kt][vt], 0, 0, 0);
          }
        }
      }
#pragma unroll
      for (int kt = 0; kt < 2; ++kt)
#pragma unroll
        for (int g = 0; g < 4; ++g) {
          const f32x4 gq = *(const f32x4*)((const float*)(wl + M3_G) + 32 * kt + 8 * g + 4 * hh);
#pragma unroll
          for (int vt = 0; vt < 2; ++vt) {
            H[kt][vt][4 * g + 0] *= gq.x; H[kt][vt][4 * g + 1] *= gq.y; H[kt][vt][4 * g + 2] *= gq.z; H[kt][vt][4 * g + 3] *= gq.w;
          }
        }
      __builtin_amdgcn_wave_barrier();
    }
  }
}

template <int T>
__device__ __forceinline__ void m1_recur(const float* zt, float (&D)[16], float (&Dp)[16], const float (&vs)[16]) {
  float sa = D[T], sp = Dp[T];
  if constexpr (T > 0) {
    constexpr int NQ = (T + 3) / 4;
#pragma unroll
    for (int q = 0; q < NQ; ++q) {
      const f32x4 a4 = *(const f32x4*)(zt + T * 32 + 4 * q);
      const f32x4 b4 = *(const f32x4*)(zt + T * 32 + 16 + 4 * q);
#pragma unroll
      for (int i = 0; i < 4; ++i) {
        const int s_ = 4 * q + i;
        if (s_ < T) {
          sa = fmaf(vs[s_], a4[i], sa); sa = fmaf(-D[s_], b4[i], sa);
          sp = fmaf(-Dp[s_], b4[i], sp);
        }
      }
    }
  }
  D[T] = sa;
  Dp[T] = sp;
  if constexpr (T + 1 < 16) m1_recur<T + 1>(zt, D, Dp, vs);
}
__device__ __forceinline__ void m1_dots(const unsigned char* wl, const f32x16 (&H)[2][2], int c, int hh, float (&D)[16]) {
  f32x16 DT[2];
#pragma unroll
  for (int vt = 0; vt < 2; ++vt) {
#pragma unroll
    for (int r = 0; r < 16; ++r) DT[vt][r] = 0.f;
#pragma unroll
    for (int kt = 0; kt < 2; ++kt)
#pragma unroll
      for (int sp = 0; sp < 2; ++sp) {
        union { uint32_t u[4]; bf16x8 v; } hb;
#pragma unroll
        for (int jj = 0; jj < 4; ++jj) hb.u[jj] = pack2(H[kt][vt][8 * sp + 2 * jj], H[kt][vt][8 * sp + 2 * jj + 1]);
        union { uint2 u[2]; bf16x8 v; } xa;
        xa.u[0] = *(const uint2*)(wl + M3_XT + sw_off(c, 4 * kt + 2 * sp) + 8 * hh);
        xa.u[1] = *(const uint2*)(wl + M3_XT + sw_off(c, 4 * kt + 2 * sp + 1) + 8 * hh);
        DT[vt] = __builtin_amdgcn_mfma_f32_32x32x16_bf16(xa.v, hb.v, DT[vt], 0, 0, 0);
      }
  }
  float own[8], rcv[8];
#pragma unroll
  for (int r = 0; r < 8; ++r) {
    own[r] = hh ? DT[1][r] : DT[0][r];
    const float snd = hh ? DT[0][r] : DT[1][r];
    rcv[r] = __shfl_xor(snd, 32);
  }
#pragma unroll
  for (int t = 0; t < 16; ++t) {
    const int r = (t & 3) + 4 * (t >> 3);
    const int hs = (t >> 2) & 1;
    D[t] = (hs == hh) ? own[r] : rcv[r];
  }
}
template <bool NEG>
__device__ __forceinline__ void m1_update(const unsigned char* wl, f32x16 (&H)[2][2], const float (&vals)[16], int jbyte, int c, int hh) {
  float own[8], rcv[8];
#pragma unroll
  for (int jj = 0; jj < 8; ++jj) {
    own[jj] = hh ? vals[8 + jj] : vals[jj];
    const float sv = hh ? vals[jj] : vals[8 + jj];
    rcv[jj] = __shfl_xor(sv, 32);
  }
#pragma unroll
  for (int vt = 0; vt < 2; ++vt) {
    union { uint32_t u[4]; bf16x8 v; } bv;
#pragma unroll
    for (int q = 0; q < 4; ++q) {
      const float v0 = (hh == vt) ? own[2 * q] : rcv[2 * q], v1 = (hh == vt) ? own[2 * q + 1] : rcv[2 * q + 1];
      bv.u[q] = NEG ? pack2(-v0, -v1) : pack2(v0, v1);
    }
#pragma unroll
    for (int kt = 0; kt < 2; ++kt) {
      const bf16x8 a0 = *(const bf16x8*)(wl + M3_WT + (c + 32 * kt) * 64 + jbyte + 16 * hh);
      H[kt][vt] = __builtin_amdgcn_mfma_f32_32x32x16_bf16(a0, bv.v, H[kt][vt], 0, 0, 0);
    }
  }
}
__device__ __forceinline__ void m1_rescale(const unsigned char* wl, f32x16 (&H)[2][2], int hh) {
#pragma unroll
  for (int kt = 0; kt < 2; ++kt)
#pragma unroll
    for (int g = 0; g < 4; ++g) {
      const f32x4 gq = *(const f32x4*)((const float*)(wl + M3_G) + 32 * kt + 8 * g + 4 * hh);
#pragma unroll
      for (int vt = 0; vt < 2; ++vt) {
        H[kt][vt][4 * g + 0] *= gq.x; H[kt][vt][4 * g + 1] *= gq.y; H[kt][vt][4 * g + 2] *= gq.z; H[kt][vt][4 * g + 3] *= gq.w;
      }
    }
}

template <int T, bool ISP>
__device__ __forceinline__ void m1_recur1(const float* zt, float (&D)[16], const float (&vs)[16]) {
  float sa = D[T];
  if constexpr (T > 0) {
    constexpr int NQ = (T + 3) / 4;
#pragma unroll
    for (int q = 0; q < NQ; ++q) {
      f32x4 a4 = {0.f, 0.f, 0.f, 0.f};
      if (!ISP) a4 = *(const f32x4*)(zt + T * 32 + 4 * q);
      const f32x4 b4 = *(const f32x4*)(zt + T * 32 + 16 + 4 * q);
#pragma unroll
      for (int i = 0; i < 4; ++i) {
        const int s_ = 4 * q + i;
        if (s_ < T) {
          if (!ISP) sa = fmaf(vs[s_], a4[i], sa);
          sa = fmaf(-D[s_], b4[i], sa);
        }
      }
    }
  }
  D[T] = sa;
  if constexpr (T + 1 < 16) m1_recur1<T + 1, ISP>(zt, D, vs);
}

template <bool ISP>
__device__ __forceinline__ void scan1_unit(const Params& p, unsigned char* wl, int bh, int cidx, int lane) {
  const int c = lane & 31, hh = lane >> 5;
  unsigned char* ws = p.ws;
  float* dstbuf = ISP ? SCAN_P(p) : SCAN_SLOC(p);
  const bf16_t* kkb = (const bf16_t*)(ws + SLOT(1));
  const bf16_t* kb = (const bf16_t*)(ws + SLOT(3));
  const bf16_t* vb = (const bf16_t*)(ws + SLOT(4));
  const bf16_t* bb = (const bf16_t*)(ws + SLOT(6));
  const bf16_t* eb = (const bf16_t*)p.out;
  const int b = bh >> 4, h = bh & 15;
  f32x16 H[2][2];
  int cl = c, hl = hh;
  asm volatile("" : "+v"(cl), "+v"(hl));
#pragma unroll
  for (int kt = 0; kt < 2; ++kt)
#pragma unroll
    for (int vt = 0; vt < 2; ++vt)
#pragma unroll
      for (int r = 0; r < 16; ++r)
        H[kt][vt][r] = (ISP && ((32 * kt + (r & 3) + 8 * (r >> 2) + 4 * hl) == (cl + 32 * vt))) ? 1.f : 0.f;
  const int row0 = b * T_ + cidx * CL_;
  const size_t base = (size_t)row0 * 1024 + h * 64 + lane;
  uint32_t rkk[16], re[16], rbv[16], rkv[16];
#pragma unroll
  for (int i = 0; i < 16; ++i) {
    const size_t o = base + (size_t)i * 1024;
    rkk[i] = kkb[o]; re[i] = eb[o]; rbv[i] = bb[o];
    if (!ISP) rkv[i] = kb[o];
  }
#pragma unroll 1
  for (int stg = 0; stg < CL_ / 16; ++stg) {
    const int step0 = stg * 16;
    float G = 1.0f;
    uint32_t rvv[16];
    if (!ISP) {
#pragma unroll
      for (int i = 0; i < 16; ++i) rvv[i] = vb[base + (size_t)(step0 + i) * 1024];
    }
    {
#pragma unroll
      for (int s_ = 0; s_ < 16; ++s_) {
        const float kkt = bf2f(rkk[s_]) * G;
        G *= __expf(-bf2f(re[s_]));
        const float iG = __builtin_amdgcn_rcpf(G);
        const uint32_t bbit = f2bf(bf2f(rbv[s_]) * iG);
        const int co = (lane & 7) * 2, ch = lane >> 3;
        *(bf16_t*)(wl + M3_XT + sw_off(s_, ch) + co) = (bf16_t)f2bf(kkt);
        *(bf16_t*)(wl + M3_W + sw_off(16 + s_, ch) + co) = (bf16_t)bbit;
        *(bf16_t*)(wl + M3_WT + lane * 64 + 32 + s_ * 2) = (bf16_t)bbit;
        if (!ISP) {
          const uint32_t kbit = f2bf(bf2f(rkv[s_]) * iG);
          *(bf16_t*)(wl + M3_W + sw_off(s_, ch) + co) = (bf16_t)kbit;
          *(bf16_t*)(wl + M3_WT + lane * 64 + s_ * 2) = (bf16_t)kbit;
        }
      }
      ((float*)(wl + M3_G))[lane] = G;
    }
    if (stg + 1 < CL_ / 16) {
#pragma unroll
      for (int i = 0; i < 16; ++i) {
        const size_t o = base + (size_t)(step0 + 16 + i) * 1024;
        rkk[i] = kkb[o]; re[i] = eb[o]; rbv[i] = bb[o];
        if (!ISP) rkv[i] = kb[o];
      }
    }
    __builtin_amdgcn_wave_barrier();
    {
      f32x16 z;
#pragma unroll
      for (int r = 0; r < 16; ++r) z[r] = 0.f;
#pragma unroll
      for (int ks = 0; ks < 4; ++ks) {
        const bf16x8 a = *(const bf16x8*)(wl + M3_W + sw_off(c, 2 * ks + hh));
        const bf16x8 bq = *(const bf16x8*)(wl + M3_XT + sw_off(c, 2 * ks + hh));
        z = __builtin_amdgcn_mfma_f32_32x32x16_bf16(a, bq, z, 0, 0, 0);
      }
      float* zt = (float*)(wl + M3_Z);
#pragma unroll
      for (int g = 0; g < 4; ++g)
        *(f32x4*)(zt + c * 32 + 8 * g + 4 * hh) = (f32x4){z[4 * g], z[4 * g + 1], z[4 * g + 2], z[4 * g + 3]};
    }
    float D[16];
    m1_dots(wl, H, c, hh, D);
    float vs[16];
#pragma unroll
    for (int i = 0; i < 16; ++i) vs[i] = ISP ? 0.f : bf2f(rvv[i]);
    __builtin_amdgcn_wave_barrier();
    m1_recur1<0, ISP>((const float*)(wl + M3_Z), D, vs);
    if (!ISP) m1_update<false>(wl, H, vs, 0, c, hh);
    m1_update<true>(wl, H, D, 32, c, hh);
    m1_rescale(wl, H, hh);
    __builtin_amdgcn_wave_barrier();
  }
#pragma unroll
  for (int kt = 0; kt < 2; ++kt)
#pragma unroll
    for (int vt = 0; vt < 2; ++vt)
#pragma unroll
      for (int g = 0; g < 4; ++g) {
        const size_t o = ((size_t)(bh * NC_ + cidx) * 64 + (c + 32 * vt)) * 64 + 32 * kt + 8 * g + 4 * hh;
        *(f32x4*)(dstbuf + o) = (f32x4){H[kt][vt][4 * g], H[kt][vt][4 * g + 1], H[kt][vt][4 * g + 2], H[kt][vt][4 * g + 3]};
      }
}

__device__ __forceinline__ void phase_scan1_mfma(const Params& p, unsigned char* smem) {
  const int lane = threadIdx.x & 63, w = __builtin_amdgcn_readfirstlane(threadIdx.x >> 6);
  unsigned char* wl = smem + w * M3_WAVE_BYTES;
  const int wg = blockIdx.x * 4 + w, nw = gridDim.x * 4;
  for (int u = wg; u < 2 * 64 * (NC_ - 1); u += nw) {
    const int unit = u >> 1;
    const int bh = unit / (NC_ - 1), cidx = unit - bh * (NC_ - 1);
    if (u & 1) scan1_unit<true>(p, wl, bh, cidx, lane);
    else scan1_unit<false>(p, wl, bh, cidx, lane);
  }
}

__device__ __forceinline__ unsigned char* opart_region(unsigned char* ws, int j, int b) {
  if (j == 0) return ws + SLOT(1) + (size_t)b * 16 * MB_;
  if (j == 1) return ws + SLOT(2) + (size_t)b * 16 * MB_;
  if (b < 3) return ws + SLOT(7) + (size_t)(b + 1) * 16 * MB_;
  return ws + OFF_P;
}

__device__ __forceinline__ void phase_gate(const Params& p, unsigned char* smem) {
  const bf16_t* Qb = (const bf16_t*)(p.ws + SLOT(5));
  const float* kpart = (const float*)(p.ws + OFF_KPART);
  uint32_t* sel = (uint32_t*)(p.ws + OFF_SEL);
  float* km = (float*)smem;
  const int tid = fresh_tid();
  for (int unit = blockIdx.x; unit < 64 * 32; unit += gridDim.x) {
    const int bh = unit >> 5, cb = unit & 31;
    __syncthreads();
    for (int i = tid; i < cb * 64; i += NTHREADS) {
      const float* kp = kpart + ((size_t)(bh * 32 + (i >> 6)) * 4) * 64 + (i & 63);
      km[i] = ((kp[0] + kp[64]) + (kp[128] + kp[192])) * (1.0f / 256.0f);
    }
    __syncthreads();
    const int t = cb * 256 + tid;
    const uint4* qp = (const uint4*)(Qb + ((size_t)bh * T_ + t) * 64);
    float q[64];
#pragma unroll
    for (int i = 0; i < 8; ++i) {
      uint4 u = qp[i];
      q[8 * i + 0] = lo_f(u.x); q[8 * i + 1] = hi_f(u.x); q[8 * i + 2] = lo_f(u.y); q[8 * i + 3] = hi_f(u.y);
      q[8 * i + 4] = lo_f(u.z); q[8 * i + 5] = hi_f(u.z); q[8 * i + 6] = lo_f(u.w); q[8 * i + 7] = hi_f(u.w);
    }
    float b0 = -3e38f, b1 = -3e38f, b2 = -3e38f;
    int i0 = 255, i1 = 255, i2 = 255;
    for (int n = 0; n < cb; ++n) {
      const float4* kp = (const float4*)(km + n * 64);
      float s0 = 0.f, s1 = 0.f;
#pragma unroll
      for (int i = 0; i < 16; ++i) {
        float4 kv = kp[i];
        s0 = fmaf(q[4 * i], kv.x, s0); s1 = fmaf(q[4 * i + 1], kv.y, s1);
        s0 = fmaf(q[4 * i + 2], kv.z, s0); s1 = fmaf(q[4 * i + 3], kv.w, s1);
      }
      const float s = s0 + s1;
      if (s > b0) { b2 = b1; i2 = i1; b1 = b0; i1 = i0; b0 = s; i0 = n; }
      else if (s > b1) { b2 = b1; i2 = i1; b1 = s; i1 = n; }
      else if (s > b2) { b2 = s; i2 = n; }
    }
    sel[(size_t)bh * T_ + t] = (uint32_t)i0 | ((uint32_t)i1 << 8) | ((uint32_t)i2 << 16);
  }
}

__device__ __forceinline__ int list_off(int n) { return n * T_ - 128 * n * (n + 1); }

__device__ __forceinline__ void phase_lists(const Params& p) {
  const uint32_t* sel = (const uint32_t*)(p.ws + OFF_SEL);
  uint16_t* lists = (uint16_t*)(p.ws + SLOT(7));
  int* cnt = (int*)(p.ws + OFF_CNT);
  const int lane = threadIdx.x & 63;
  const int wg = blockIdx.x * 4 + (threadIdx.x >> 6), nw = gridDim.x * 4;
  for (int unit = wg; unit < 64 * 31; unit += nw) {
    const int bh = unit / 31, n = unit - bh * 31;
    uint16_t* lp = lists + (size_t)bh * 126976 + list_off(n);
    int base = 0;
    uint4 s4n = *(const uint4*)(sel + (size_t)bh * T_ + (n + 1) * 256 + lane * 4);
    for (int t0 = (n + 1) * 256; t0 < T_; t0 += 256) {
      const uint4 s4 = s4n;
      if (t0 + 256 < T_) s4n = *(const uint4*)(sel + (size_t)bh * T_ + t0 + 256 + lane * 4);
      const uint32_t sv[4] = {s4.x, s4.y, s4.z, s4.w};
#pragma unroll
      for (int q = 0; q < 4; ++q) {
        const int t = t0 + lane * 4 + q;
        const uint32_t s = sv[q];
        int j = -1;
        if ((int)(s & 255u) == n) j = 0;
        else if ((int)((s >> 8) & 255u) == n) j = 1;
        else if ((int)((s >> 16) & 255u) == n) j = 2;
        const unsigned long long mask = __ballot(j >= 0);
        if (j >= 0) {
          int pos = base + __popcll(mask & ((1ull << lane) - 1ull));
          lp[pos] = (uint16_t)(t | (j << 13));
        }
        base += __popcll(mask);
      }
    }
    if (lane == 0) cnt[unit] = base;
  }
}

__device__ __forceinline__ void load_kv_block(const bf16_t* Kblk, const bf16_t* Vtblk, unsigned char* smem) {
  const int tid = fresh_tid();
  {
    const int c8 = tid & 7, r32 = tid >> 3;
#pragma unroll
    for (int pp = 0; pp < 8; ++pp) {
      int row = r32 + 32 * pp;
      uint4 v = *(const uint4*)(Kblk + (size_t)row * 64 + c8 * 8);
      *(uint4*)(smem + sw_off(row, c8)) = v;
    }
  }
  {
    const int c32 = tid & 31, r8 = tid >> 5;
#pragma unroll
    for (int pp = 0; pp < 8; ++pp) {
      int row = r8 + 8 * pp;
      uint4 v = *(const uint4*)(Vtblk + (size_t)row * T_ + c32 * 8);
      unsigned char* d = smem + 32768 + row * 520 + c32 * 16;
      *(uint2*)d = make_uint2(v.x, v.y);
      *(uint2*)(d + 8) = make_uint2(v.z, v.w);
    }
  }
}

struct KVRegs { u32x4 k[8], v[8]; };
__device__ __forceinline__ void kv_gload(const bf16_t* Kblk, const bf16_t* Vtblk, KVRegs& r) {
  const int tid = fresh_tid();
  const int c8 = tid & 7, r32 = tid >> 3, c32 = tid & 31, r8 = tid >> 5;
#pragma unroll
  for (int pp = 0; pp < 8; ++pp) {
    r.k[pp] = *(const u32x4*)(Kblk + (size_t)(r32 + 32 * pp) * 64 + c8 * 8);
    r.v[pp] = *(const u32x4*)(Vtblk + (size_t)(r8 + 8 * pp) * T_ + c32 * 8);
  }
}
__device__ __forceinline__ void kv_lstore(const KVRegs& r, unsigned char* smem) {
  const int tid = fresh_tid();
  const int c8 = tid & 7, r32 = tid >> 3, c32 = tid & 31, r8 = tid >> 5;
#pragma unroll
  for (int pp = 0; pp < 8; ++pp) {
    *(u32x4*)(smem + sw_off(r32 + 32 * pp, c8)) = r.k[pp];
    unsigned char* d = smem + 32768 + (r8 + 8 * pp) * 520 + c32 * 16;
    *(uint2*)d = make_uint2(r.v[pp].x, r.v[pp].y);
    *(uint2*)(d + 8) = make_uint2(r.v[pp].z, r.v[pp].w);
  }
}

template <bool CAUSAL>
__device__ __forceinline__ void attn_wave(const unsigned char* smem, const bf16x8 (&qb)[4], int kt_end, int qpos_rel,
                                          f32x16 (&O)[2], float& m_out, float& l_out) {
  const int lane = fresh_tid() & 63;
  const int c = lane & 31, hh = lane >> 5;
#pragma unroll
  for (int i = 0; i < 2; ++i)
#pragma unroll
    for (int r = 0; r < 16; ++r) O[i][r] = 0.f;
  float m = -1e30f, l = 0.f;
  for (int kt = 0; kt <= kt_end; ++kt) {
    f32x16 s[2];
#pragma unroll
    for (int ti = 0; ti < 2; ++ti) {
#pragma unroll
      for (int r = 0; r < 16; ++r) s[ti][r] = 0.f;
      const int krow = kt * 64 + ti * 32 + c;
#pragma unroll
      for (int ks = 0; ks < 4; ++ks) {
        bf16x8 a = *(const bf16x8*)(smem + sw_off(krow, ks * 2 + hh));
        s[ti] = __builtin_amdgcn_mfma_f32_32x32x16_bf16(a, qb[ks], s[ti], 0, 0, 0);
      }
    }
    float mx = -1e30f;
#pragma unroll
    for (int ti = 0; ti < 2; ++ti)
#pragma unroll
      for (int r = 0; r < 16; ++r) {
        int key = kt * 64 + ti * 32 + (r & 3) + 8 * (r >> 2) + 4 * hh;
        if (CAUSAL && key > qpos_rel) s[ti][r] = -1e30f;
        mx = fmaxf(mx, s[ti][r]);
      }
    mx = fmaxf(mx, __shfl_xor(mx, 32));
    const float mn = fmaxf(m, mx);
    const float alpha = __builtin_amdgcn_exp2f(m - mn);
    m = mn;
    float ps = 0.f;
#pragma unroll
    for (int ti = 0; ti < 2; ++ti)
#pragma unroll
      for (int r = 0; r < 16; ++r) {
        float pv = __builtin_amdgcn_exp2f(s[ti][r] - mn);
        s[ti][r] = pv;
        ps += pv;
      }
    l = l * alpha + ps;
#pragma unroll
    for (int i = 0; i < 2; ++i)
#pragma unroll
      for (int r = 0; r < 16; ++r) O[i][r] *= alpha;
#pragma unroll
    for (int ti = 0; ti < 2; ++ti)
#pragma unroll
      for (int sp = 0; sp < 2; ++sp) {
        union { uint32_t u[4]; bf16x8 v; } pb;
#pragma unroll
        for (int jj = 0; jj < 4; ++jj) pb.u[jj] = pack2(s[ti][8 * sp + 2 * jj], s[ti][8 * sp + 2 * jj + 1]);
        const int keyb = kt * 64 + ti * 32 + 16 * sp + 4 * hh;
#pragma unroll
        for (int dt = 0; dt < 2; ++dt) {
          const unsigned char* vp = smem + 32768 + (dt * 32 + c) * 520 + keyb * 2;
          union { uint2 u[2]; bf16x8 v; } va;
          va.u[0] = *(const uint2*)vp;
          va.u[1] = *(const uint2*)(vp + 16);
          O[dt] = __builtin_amdgcn_mfma_f32_32x32x16_bf16(va.v, pb.v, O[dt], 0, 0, 0);
        }
      }
  }
  l += __shfl_xor(l, 32);
  m_out = m;
  l_out = l;
}

__device__ __forceinline__ void phase_attn_sel(const Params& p, unsigned char* smem) {
  unsigned char* ws = p.ws;
  const bf16_t* Kb = (const bf16_t*)(ws + SLOT(3));
  const bf16_t* Vt = (const bf16_t*)(ws + SLOT(4));
  const bf16_t* Qb = (const bf16_t*)(ws + SLOT(5));
  const uint16_t* lists = (const uint16_t*)(ws + SLOT(7));
  const int* cnt = (const int*)(ws + OFF_CNT);
  float2* ML = (float2*)(ws + OFF_ML);
  const int tid_ = fresh_tid();
  const int lane = tid_ & 63, w = tid_ >> 6;
  const int c = lane & 31, hh = lane >> 5;
  for (int pid = blockIdx.x; pid < 64 * 31 * 8; pid += gridDim.x) {
    const int part = pid / 1984, u = pid - part * 1984;
    const int bh = u / 31, n = u - bh * 31;
    if (part * 8 * 128 >= T_ - (n + 1) * 256) continue;
    const int count = cnt[u];
    const int ntiles = (count + 127) >> 7;
    if (part * 8 >= ntiles) continue;
    const int b = bh >> 4, h = bh & 15;
    __syncthreads();
    load_kv_block(Kb + ((size_t)bh * T_ + n * 256) * 64, Vt + (size_t)bh * 64 * T_ + n * 256, smem);
    __syncthreads();
    const int qend = (part * 8 + 8 < ntiles) ? part * 8 + 8 : ntiles;
    uint32_t ent[8];
    const uint16_t* lp = lists + (size_t)bh * 126976 + list_off(n);
#pragma unroll
    for (int i = 0; i < 8; ++i) {
      int ei = (part * 8 + i) * 128 + 32 * w + c;
      if (ei > count - 1) ei = count - 1;
      ent[i] = lp[ei];
    }
    bf16x8 qn[4];
    {
      const bf16_t* qp = Qb + ((size_t)bh * T_ + (ent[0] & 0x1fff)) * 64;
#pragma unroll
      for (int ks = 0; ks < 4; ++ks) qn[ks] = *(const bf16x8*)(qp + ks * 16 + 8 * hh);
    }
#pragma unroll
    for (int i = 0; i < 8; ++i) {
      const int q = part * 8 + i;
      if (q < qend) {
        const int e0 = q * 128 + 32 * w;
        const uint32_t e = ent[i];
        bf16x8 qb[4];
#pragma unroll
        for (int ks = 0; ks < 4; ++ks) qb[ks] = qn[ks];
        if (i + 1 < 8 && q + 1 < qend) {
          const bf16_t* qp = Qb + ((size_t)bh * T_ + (ent[(i + 1) & 7] & 0x1fff)) * 64;
#pragma unroll
          for (int ks = 0; ks < 4; ++ks) qn[ks] = *(const bf16x8*)(qp + ks * 16 + 8 * hh);
        }
        if (e0 < count) {
          const bool valid = e0 + c < count;
          const int t = e & 0x1fff, j = e >> 13;
          f32x16 O[2];
          float m, l;
          attn_wave<false>(smem, qb, 3, 1 << 30, O, m, l);
          if (valid) {
            const float inv = 1.0f / l;
            unsigned char* reg = opart_region(ws, j, b);
            bf16_t* op = (bf16_t*)reg + ((size_t)h * T_ + t) * 64;
#pragma unroll
            for (int dt = 0; dt < 2; ++dt)
#pragma unroll
              for (int g = 0; g < 4; ++g) {
                uint2 o;
                o.x = pack2(O[dt][4 * g] * inv, O[dt][4 * g + 1] * inv);
                o.y = pack2(O[dt][4 * g + 2] * inv, O[dt][4 * g + 3] * inv);
                *(uint2*)(op + dt * 32 + 8 * g + 4 * hh) = o;
              }
            if (hh == 0) ML[((size_t)j * 64 + bh) * T_ + t] = make_float2(m, l);
          }
        }
      }
    }
  }
}

__device__ __forceinline__ void phase_attn_own(const Params& p, unsigned char* smem) {
  unsigned char* ws = p.ws;
  const bf16_t* Kb = (const bf16_t*)(ws + SLOT(3));
  const bf16_t* Vt = (const bf16_t*)(ws + SLOT(4));
  const bf16_t* Qb = (const bf16_t*)(ws + SLOT(5));
  bf16_t* sgb = (bf16_t*)(ws + SLOT(6));
  const uint32_t* sel = (const uint32_t*)(ws + OFF_SEL);
  const float2* ML = (const float2*)(ws + OFF_ML);
  const int tid_ = fresh_tid();
  const int lane = tid_ & 63, w = tid_ >> 6;
  const int c = lane & 31, hh = lane >> 5;
  KVRegs kvr;
  if ((int)blockIdx.x < 64 * 32 * 2) {
    const int bh0 = blockIdx.x >> 6, cb0 = (blockIdx.x >> 1) & 31;
    kv_gload(Kb + ((size_t)bh0 * T_ + cb0 * 256) * 64, Vt + (size_t)bh0 * 64 * T_ + cb0 * 256, kvr);
  }
  for (int id = blockIdx.x; id < 64 * 32 * 2; id += gridDim.x) {
    const int bh = id >> 6, cb = (id >> 1) & 31, qo = (id & 1) * 128;
    const int b = bh >> 4, h = bh & 15;
    __syncthreads();
    kv_lstore(kvr, smem);
    __syncthreads();
    {
      const int idn = id + gridDim.x;
      if (idn < 64 * 32 * 2) {
        const int bhn = idn >> 6, cbn = (idn >> 1) & 31;
        kv_gload(Kb + ((size_t)bhn * T_ + cbn * 256) * 64, Vt + (size_t)bhn * 64 * T_ + cbn * 256, kvr);
      }
    }
    const int qrel = qo + 32 * w + c;
    const int t = cb * 256 + qrel;
    const bf16_t* qp = Qb + ((size_t)bh * T_ + t) * 64;
    bf16x8 qb[4];
#pragma unroll
    for (int ks = 0; ks < 4; ++ks) qb[ks] = *(const bf16x8*)(qp + ks * 16 + 8 * hh);
    f32x16 O[2];
    float m, l;
    attn_wave<true>(smem, qb, (qo + 32 * w + 31) >> 6, qrel, O, m, l);
    const uint32_t s = sel[(size_t)bh * T_ + t];
    float mj[3], lj[3];
    bool vj[3];
    float Mx = m;
#pragma unroll
    for (int j = 0; j < 3; ++j) {
      vj[j] = ((s >> (8 * j)) & 255u) < 32u;
      float2 ml = ML[((size_t)j * 64 + bh) * T_ + t];
      mj[j] = vj[j] ? ml.x : -1e30f;
      lj[j] = vj[j] ? ml.y : 0.f;
      Mx = fmaxf(Mx, mj[j]);
    }
    const float wo = __builtin_amdgcn_exp2f(m - Mx);
    float den = l * wo;
    float wj[3];
#pragma unroll
    for (int j = 0; j < 3; ++j) {
      wj[j] = vj[j] ? lj[j] * __builtin_amdgcn_exp2f(mj[j] - Mx) : 0.f;
      den += wj[j];
    }
    const float inv = 1.0f / den;
    bf16_t* gp = sgb + ((size_t)(b * T_ + t)) * 1024 + h * 64;
#pragma unroll
    for (int dt = 0; dt < 2; ++dt)
#pragma unroll
      for (int g = 0; g < 4; ++g) {
        const int d0 = dt * 32 + 8 * g + 4 * hh;
        float o0 = O[dt][4 * g] * wo, o1 = O[dt][4 * g + 1] * wo, o2 = O[dt][4 * g + 2] * wo, o3 = O[dt][4 * g + 3] * wo;
#pragma unroll
        for (int j = 0; j < 3; ++j) {
          const bf16_t* op = (const bf16_t*)opart_region(ws, j, b) + ((size_t)h * T_ + t) * 64 + d0;
          uint2 u = *(const uint2*)op;
          if (!vj[j]) u = make_uint2(0u, 0u);
          o0 = fmaf(lo_f(u.x), wj[j], o0); o1 = fmaf(hi_f(u.x), wj[j], o1);
          o2 = fmaf(lo_f(u.y), wj[j], o2); o3 = fmaf(hi_f(u.y), wj[j], o3);
        }
        uint2 gv = *(const uint2*)(gp + d0);
        uint2 r;
        r.x = pack2(o0 * inv * lo_f(gv.x), o1 * inv * hi_f(gv.x));
        r.y = pack2(o2 * inv * lo_f(gv.y), o3 * inv * hi_f(gv.y));
        *(uint2*)(gp + d0) = r;
      }
  }
}

#define XB_TMO      128
#define XB_XCNT(j)  (256  + 64 * (j))
#define XB_XSUB(j)  (1280 + 64 * (j))
#define XB_XGEN(j)  (2304 + 64 * (j))
#define XB_TOP      3328
#define XB_TOPGEN   3392
#define XCD_BAR_WORDS 3456
#define XB_SPIN_CAP (1u << 18)
#define LAS __attribute__((address_space(3)))

__device__ __forceinline__ unsigned xb_ld(unsigned* p)              { return __hip_atomic_load(p, __ATOMIC_RELAXED, __HIP_MEMORY_SCOPE_AGENT); }
__device__ __forceinline__ unsigned xb_add(unsigned* p, unsigned v) { return __hip_atomic_fetch_add(p, v, __ATOMIC_RELAXED, __HIP_MEMORY_SCOPE_AGENT); }
__device__ __forceinline__ unsigned xb_xcc_id() { return (unsigned)__builtin_amdgcn_s_getreg((3 << 11) | 20) & 0xFu; }
#define XB_SPIN(cond, bar) do { unsigned _sp = 0; while (cond) { __builtin_amdgcn_s_sleep(1); \
    if ((++_sp & 255u) == 0u) { if (xb_ld(&(bar)[XB_TMO])) break; if (_sp > XB_SPIN_CAP) { atomicAdd(&(bar)[XB_TMO], 1u); break; } } } } while (0)

struct XcdBarrier {
    unsigned* bar; unsigned x;
    volatile LAS unsigned* st;
};

__device__ __forceinline__ XcdBarrier xcd_barrier_post(unsigned* bar, volatile LAS unsigned* st) {
    XcdBarrier b; b.bar = bar; b.x = xb_xcc_id(); b.st = st;
    if (threadIdx.x == 0) (void)xb_add(&bar[XB_XCNT(b.x)], 1u);
    return b;
}
__device__ __forceinline__ void xcd_barrier_complete(unsigned* bar, unsigned x, unsigned& nloc, unsigned& nx) {
    const unsigned G = gridDim.x * gridDim.y * gridDim.z;
    unsigned sum, cnt, mine, sp = 0u;
    for (;;) {
        sum = 0u; cnt = 0u; mine = 0u;
#pragma unroll
        for (unsigned j = 0; j < 16; ++j) { const unsigned c = xb_ld(&bar[XB_XCNT(j)]); sum += c; cnt += (c > 0u) ? 1u : 0u; mine = (j == x) ? c : mine; }
        if (sum == G) break;
        __builtin_amdgcn_s_sleep(1);
        if ((++sp & 255u) == 0u) { if (xb_ld(&bar[XB_TMO])) break; if (sp > XB_SPIN_CAP) { atomicAdd(&bar[XB_TMO], 1u); break; } }
    }
    nloc = mine > 0u ? mine : 1u; nx = cnt > 0u ? cnt : 1u;
}

__device__ __forceinline__ void xcd_barrier(const XcdBarrier& b) {
    asm volatile("s_waitcnt vmcnt(0)" ::: "memory");
    __syncthreads();
    if (threadIdx.x == 0) {
        unsigned* bar = b.bar;
        __builtin_amdgcn_s_waitcnt(0);
        unsigned nloc = b.st[0], nx = b.st[1];
        if (nloc == 0u) { xcd_barrier_complete(bar, b.x, nloc, nx); b.st[0] = nloc; b.st[1] = nx; }
        const unsigned old = xb_add(&bar[XB_XSUB(b.x)], 1u);
        const unsigned gen = old / nloc;
        if (old + 1u == (gen + 1u) * nloc) {
            __builtin_amdgcn_fence(__ATOMIC_RELEASE, "agent");
            asm volatile("s_waitcnt vmcnt(0)" ::: "memory");
            const unsigned og = xb_add(&bar[XB_TOP], 1u);
            const unsigned tg = og / nx;
            if (og + 1u == (tg + 1u) * nx) xb_add(&bar[XB_TOPGEN], 1u);
            else XB_SPIN(xb_ld(&bar[XB_TOPGEN]) == tg, bar);
            __builtin_amdgcn_fence(__ATOMIC_ACQUIRE, "agent");
            xb_add(&bar[XB_XGEN(b.x)], 1u);
            asm volatile("s_waitcnt vmcnt(0)" ::: "memory");
        } else {
            XB_SPIN(xb_ld(&bar[XB_XGEN(b.x)]) == gen, bar);
            __builtin_amdgcn_fence(__ATOMIC_ACQUIRE, "agent");
            asm volatile("s_waitcnt vmcnt(0)" ::: "memory");
        }
    }
    __syncthreads();
}

__global__ void __launch_bounds__(NTHREADS, 2) yoco_fwd(Params p) {
  cg::grid_group grid = cg::this_grid();
  extern __shared__ __attribute__((aligned(16))) unsigned char smem[];
  unsigned char* ws = p.ws;
  const int tid = threadIdx.x;
  __shared__ uint4 xb_words;
  if (tid == 0) xb_words = make_uint4(0u, 0u, 0u, 0u);
  __syncthreads();
  XcdBarrier xb = xcd_barrier_post((unsigned*)(ws + OFF_BAR), (volatile LAS unsigned*)&xb_words);

  {
    float* tl = (float*)smem;
    const bool defer_b = gridDim.x >= 512;
    for (int j = blockIdx.x; j < 2624 + 64; j += gridDim.x) {
      if (defer_b && j >= 1056 && j < 2592) continue;
      if (j < 1056) transpose_job(p.w_in_a, 4224, 1024, (bf16_t*)(ws + OFF_WT_IN_A), nullptr, j, tl);
      else if (j < 1312) transpose_job(p.w_out_a, 1024, 1024, (bf16_t*)(ws + OFF_WT_OUT_A), nullptr, j - 1056, tl);
      else if (j < 1824) transpose_job(p.w_kv, 2048, 1024, (bf16_t*)(ws + OFF_WT_KVQ), p.norm_kv, j - 1312, tl);
      else if (j < 2336) transpose_job(p.w_in_b, 2048, 1024, (bf16_t*)(ws + OFF_WT_KVQ) + (size_t)2048 * 1024, p.norm_b, j - 1824, tl);
      else if (j < 2592) transpose_job(p.w_out_b, 1024, 1024, (bf16_t*)(ws + OFF_WT_OUT_B), nullptr, j - 2336, tl);
      else if (j < 2608) transpose_job(p.w2, 1024, 64, (bf16_t*)(ws + OFF_W2T), nullptr, j - 2592, tl);
      else if (j < 2624) transpose_job(p.a2, 1024, 64, (bf16_t*)(ws + OFF_A2T), nullptr, j - 2608, tl);
      else {
        const int q = j - 2624;
        const int grp = q >> 5, half = (q >> 4) & 1, kt = q & 15;
        transpose_tile(p.w_in_a, 4224, kt * 64, grp == 0 ? 1024 : 3136, (bf16_t*)(ws + OFF_WT_SMALL), 2048, grp * 64, half * 1024,
                       p.mu_a + (grp == 0 ? 1 : 4) * 1024, half == 0 ? 2 : 1, tl);
      }
    }
    float2* rope = (float2*)(ws + OFF_ROPE);
    for (int i = blockIdx.x * NTHREADS + tid; i < T_ * 8; i += gridDim.x * NTHREADS) {
      const int t = i >> 3, f = i & 7;
      const double invf[8] = {1.0, 0.19392274474868576, 0.03760603093086393, 0.007292664737217109,
                              0.001414213562373095, 0.0002742481756762073, 5.318295896944988e-05, 1.031338537721246e-05};
      double fr = 0.0;
      fr = (f == 0) ? invf[0] : fr; fr = (f == 1) ? invf[1] : fr; fr = (f == 2) ? invf[2] : fr; fr = (f == 3) ? invf[3] : fr;
      fr = (f == 4) ? invf[4] : fr; fr = (f == 5) ? invf[5] : fr; fr = (f == 6) ? invf[6] : fr; fr = (f == 7) ? invf[7] : fr;
      double ang = (double)((float)t * (float)fr);
      double rev = ang * 0.15915494309189535;
      rev = rev - floor(rev + 0.5);
      float rr = (float)(rev * 6.283185307179586);
      rope[i] = make_float2(__cosf(rr), __sinf(rr));
    }
    norm_mix_rows(p);
  }
  if (p.ws == nullptr) grid.sync();
  xcd_barrier(xb);
  phase_gemm1(p, smem);
  xcd_barrier(xb);
  phase_prep2(p);
  xcd_barrier(xb);
  phase_scan1_mfma(p, smem);
  xcd_barrier(xb);
  phase_scan2(p, smem);
  xcd_barrier(xb);
  phase_scan3_mfma(p, smem);
  xcd_barrier(xb);
  phase_gemm_res((const bf16_t*)(ws + SLOT(7)), (const bf16_t*)(ws + OFF_WT_OUT_A), p.x, p.out, smem);
  xcd_barrier(xb);
  rmsnorm_rows(p.out, nullptr, (bf16_t*)(ws + SLOT(1)));
  xcd_barrier(xb);
  phase_gemm_kvq(p, smem);
  xcd_barrier(xb);
  phase_gate(p, smem);
  xcd_barrier(xb);
  phase_lists(p);
  xcd_barrier(xb);
  phase_attn_sel(p, smem);
  xcd_barrier(xb);
  phase_attn_own(p, smem);
  xcd_barrier(xb);
  phase_gemm_res((const bf16_t*)(ws + SLOT(6)), (const bf16_t*)(ws + OFF_WT_OUT_B), p.out, p.out, smem);
}

extern "C" void kernel_launch(void* const* d_in, const int* in_sizes, int n_in, void* d_out, int out_size, void* d_ws,
                              size_t ws_size, hipStream_t stream) {
  static int grid_blocks = 0;
  if (!grid_blocks) {
    int dev = 0, cus = 0, per_cu = 0;
    hipGetDevice(&dev);
    hipDeviceGetAttribute(&cus, hipDeviceAttributeMultiprocessorCount, dev);
    hipFuncSetAttribute((const void*)yoco_fwd, hipFuncAttributeMaxDynamicSharedMemorySize, SMEM_BYTES);
    hipOccupancyMaxActiveBlocksPerMultiprocessor(&per_cu, (const void*)yoco_fwd, NTHREADS, SMEM_BYTES);
    if (per_cu < 1) per_cu = 1;
    if (per_cu > 2) per_cu = 2;
    grid_blocks = cus * per_cu;
    if (ws_size < SLOT(8)) fprintf(stderr, "workspace too small: %zu\n", ws_size);
  }
  (void)hipMemsetAsync((unsigned char*)d_ws + OFF_BAR, 0, XCD_BAR_WORDS * 4, stream);
  Params p{};
  const float** pp = (const float**)&p;
  for (int i = 0; i < 21; ++i) pp[i] = (const float*)d_in[i];
  p.out = (float*)d_out;
  p.ws = (unsigned char*)d_ws;
  void* args[] = {&p};
  hipError_t e = hipLaunchCooperativeKernel((const void*)yoco_fwd, dim3(grid_blocks), dim3(NTHREADS), args, SMEM_BYTES, stream);
  if (e != hipSuccess) fprintf(stderr, "cooperative launch failed: %s (grid %d)\n", hipGetErrorString(e), grid_blocks);
}
```

```cpp
#include <hip/hip_runtime.h>
#include <hip/hip_cooperative_groups.h>
#include <stdint.h>
#include <stdio.h>
namespace cg = cooperative_groups;

typedef __attribute__((ext_vector_type(8))) short bf16x8;
typedef __attribute__((ext_vector_type(16))) float f32x16;
typedef unsigned short bf16_t;
typedef __attribute__((ext_vector_type(4))) uint32_t u32x4;
typedef __bf16 bf16v2 __attribute__((ext_vector_type(2)));
typedef float f32x2 __attribute__((ext_vector_type(2)));
typedef float f32x4 __attribute__((ext_vector_type(4)));

#define T_ 8192
#define M_ 32768
#define NTHREADS 256
#define SMEM_BYTES 66560
#define MB_ ((size_t)1 << 20)
#define SLOT(i) ((size_t)(i) * 64 * MB_)
#define OFF_WT_IN_A  ((size_t)0)
#define OFF_WT_OUT_A (9 * MB_)
#define OFF_WT_KVQ   (11 * MB_)
#define OFF_WT_OUT_B (19 * MB_)
#define OFF_W2T      (21 * MB_)
#define OFF_A2T      (21 * MB_ + 131072)
#define OFF_ROPE     (21 * MB_ + 262144)
#define OFF_TWDN     (22 * MB_)
#define OFF_ADN      (26 * MB_)
#define OFF_SLOC     (30 * MB_)
#define OFF_P        (46 * MB_)
#define OFF_SC       (30 * MB_)
#define OFF_BAR      (63 * MB_)
#define OFF_WT_SMALL (62 * MB_)
#define OFF_KMEAN    (22 * MB_)
#define OFF_KPART    (40 * MB_)
#define OFF_SEL      (23 * MB_)
#define OFF_CNT      (25 * MB_)
#define OFF_ML       (26 * MB_)

#define NC_ 32
#define CL_ 256
#define TS_ 8
#define NARR_ 7

struct Params {
  const float* x; const float* norm_a; const float* mu_a; const float* w_in_a; const float* w0; const float* w2;
  const float* a0; const float* a2; const float* kk_a; const float* ka_a; const float* rk_a; const float* gn_w;
  const float* gn_b; const float* w_out_a; const float* norm_kv; const float* w_kv; const float* k_norm;
  const float* norm_b; const float* w_in_b; const float* q_norm; const float* w_out_b;
  float* out; unsigned char* ws;
};

__device__ __forceinline__ float bf2f(uint32_t u) { return __uint_as_float(u << 16); }
__device__ __forceinline__ uint32_t pack2(float a, float b) {
  f32x2 f = {a, b};
  bf16v2 r = __builtin_convertvector(f, bf16v2);
  return __builtin_bit_cast(uint32_t, r);
}
__device__ __forceinline__ uint32_t f2bf(float f) { return pack2(f, 0.f) & 0xffffu; }
__device__ __forceinline__ float lo_f(uint32_t u) { return __uint_as_float(u << 16); }
__device__ __forceinline__ float hi_f(uint32_t u) { return __uint_as_float(u & 0xffff0000u); }

template <int C>
__device__ __forceinline__ float dppf(float x) {
  return __int_as_float(__builtin_amdgcn_update_dpp(0, __float_as_int(x), C, 0xf, 0xf, true));
}
__device__ __forceinline__ float wave_sum(float x) {
  x += dppf<0xB1>(x);
  x += dppf<0x4E>(x);
  x += dppf<0x141>(x);
  x += dppf<0x140>(x);
  int xi = __float_as_int(x);
  float s = __int_as_float(__builtin_amdgcn_readlane(xi, 0)) + __int_as_float(__builtin_amdgcn_readlane(xi, 16)) +
            __int_as_float(__builtin_amdgcn_readlane(xi, 32)) + __int_as_float(__builtin_amdgcn_readlane(xi, 48));
  return s;
}
__device__ __forceinline__ float half_sum(float x) {
  x += dppf<0xB1>(x);
  x += dppf<0x4E>(x);
  x += dppf<0x141>(x);
  x += dppf<0x140>(x);
  x += __shfl_xor(x, 16);
  return x;
}
__device__ __forceinline__ int fresh_tid() {
  int t = threadIdx.x;
  asm volatile("" : "+v"(t));
  return t;
}
__device__ __forceinline__ float silu_f(float x) { return x / (1.0f + __expf(-x)); }

__device__ __forceinline__ uint32_t sw_off(int row, int c8) { return (uint32_t)(row * 128 + ((c8 ^ ((row >> 1) & 7)) << 4)); }

__device__ __forceinline__ void transpose_tile(const float* __restrict__ src, int lds, int k0, int n0s, bf16_t* dst, int ldd,
                                               int n0d, int kc0, const float* __restrict__ scale, int mode, float* tl) {
  const int tid = threadIdx.x;
  const int ty = tid >> 4, tx = tid & 15;
#pragma unroll
  for (int i = 0; i < 4; ++i) {
    int k = ty + 16 * i;
    float4 v = *(const float4*)(src + (size_t)(k0 + k) * lds + n0s + tx * 4);
    float sc = 1.0f;
    if (mode == 1) sc = scale[k0 + k];
    else if (mode == 2) sc = 1.0f - scale[k0 + k];
    tl[k * 65 + tx * 4 + 0] = v.x * sc;
    tl[k * 65 + tx * 4 + 1] = v.y * sc;
    tl[k * 65 + tx * 4 + 2] = v.z * sc;
    tl[k * 65 + tx * 4 + 3] = v.w * sc;
  }
  __syncthreads();
  const int nn = tid >> 2, kq = tid & 3;
  uint32_t o[8];
#pragma unroll
  for (int j = 0; j < 8; ++j) o[j] = pack2(tl[(kq * 16 + 2 * j) * 65 + nn], tl[(kq * 16 + 2 * j + 1) * 65 + nn]);
  uint4* dp = (uint4*)(dst + (size_t)(n0d + nn) * ldd + kc0 + k0 + kq * 16);
  dp[0] = make_uint4(o[0], o[1], o[2], o[3]);
  dp[1] = make_uint4(o[4], o[5], o[6], o[7]);
  __syncthreads();
}
__device__ __forceinline__ void transpose_job(const float* __restrict__ src, int N, int Kd, bf16_t* dst, const float* __restrict__ scale,
                                              int tile, float* tl) {
  const int ntn = N >> 6;
  const int kt = tile / ntn, nt = tile - kt * ntn;
  transpose_tile(src, N, kt * 64, nt * 64, dst, Kd, nt * 64, 0, scale, scale ? 1 : 0, tl);
}

__device__ __forceinline__ void norm_mix_rows(const Params& p) {
  unsigned char* ws = p.ws;
  bf16_t* dH = (bf16_t*)(ws + SLOT(1));
  bf16_t* dR = (bf16_t*)(ws + SLOT(6));
  bf16_t* dK = (bf16_t*)(ws + SLOT(7));
  bf16_t* dV = (bf16_t*)p.out;
  bf16_t* dG = (bf16_t*)((unsigned char*)p.out + 64 * MB_);
  const int lane = threadIdx.x & 63;
  const int wg = blockIdx.x * 4 + (threadIdx.x >> 6), nw = gridDim.x * 4;
  const int per = (M_ + nw - 1) / nw;
  const int r0 = wg * per;
  const int r1 = (r0 + per < M_) ? r0 + per : M_;
  if (r0 >= r1) return;
  float4 g4[4], m0[4], m2[4], m3[4], m5[4], hp[4];
#pragma unroll
  for (int i = 0; i < 4; ++i) {
    g4[i] = ((const float4*)p.norm_a)[lane + 64 * i];
    m0[i] = ((const float4*)(p.mu_a + 0 * 1024))[lane + 64 * i];
    m2[i] = ((const float4*)(p.mu_a + 2 * 1024))[lane + 64 * i];
    m3[i] = ((const float4*)(p.mu_a + 3 * 1024))[lane + 64 * i];
    m5[i] = ((const float4*)(p.mu_a + 5 * 1024))[lane + 64 * i];
    hp[i] = make_float4(0.f, 0.f, 0.f, 0.f);
  }
  const int rstart = ((r0 & (T_ - 1)) != 0) ? r0 - 1 : r0;
  float4 vn[4];
#pragma unroll
  for (int i = 0; i < 4; ++i) vn[i] = ((const float4*)(p.x + (size_t)rstart * 1024))[lane + 64 * i];
  for (int row = rstart; row < r1; ++row) {
    float4 v[4];
    float ss = 0.f;
#pragma unroll
    for (int i = 0; i < 4; ++i) v[i] = vn[i];
    if (row + 1 < r1) {
#pragma unroll
      for (int i = 0; i < 4; ++i) vn[i] = ((const float4*)(p.x + (size_t)(row + 1) * 1024))[lane + 64 * i];
    }
#pragma unroll
    for (int i = 0; i < 4; ++i) {
      ss += v[i].x * v[i].x + v[i].y * v[i].y + v[i].z * v[i].z + v[i].w * v[i].w;
    }
    ss = wave_sum(ss);
    const float rstd = rsqrtf(ss * (1.0f / 1024.0f) + 1e-6f);
    const bool emit = row >= r0;
    const bool first = (row & (T_ - 1)) == 0;
#pragma unroll
    for (int i = 0; i < 4; ++i) {
      float4 h = make_float4(v[i].x * rstd * g4[i].x, v[i].y * rstd * g4[i].y, v[i].z * rstd * g4[i].z, v[i].w * rstd * g4[i].w);
      float4 q = first ? make_float4(0.f, 0.f, 0.f, 0.f) : hp[i];
      hp[i] = h;
      if (emit) {
        const size_t o = (size_t)row * 1024 + (lane + 64 * i) * 4;
        const float dx = q.x - h.x, dy = q.y - h.y, dz = q.z - h.z, dw = q.w - h.w;
        *(uint2*)(dH + o) = make_uint2(pack2(h.x, h.y), pack2(h.z, h.w));
        *(uint2*)(dR + o) = make_uint2(pack2(h.x + dx * m0[i].x, h.y + dy * m0[i].y), pack2(h.z + dz * m0[i].z, h.w + dw * m0[i].w));
        *(uint2*)(dK + o) = make_uint2(pack2(h.x + dx * m2[i].x, h.y + dy * m2[i].y), pack2(h.z + dz * m2[i].z, h.w + dw * m2[i].w));
        *(uint2*)(dV + o) = make_uint2(pack2(h.x + dx * m3[i].x, h.y + dy * m3[i].y), pack2(h.z + dz * m3[i].z, h.w + dw * m3[i].w));
        *(uint2*)(dG + o) = make_uint2(pack2(h.x + dx * m5[i].x, h.y + dy * m5[i].y), pack2(h.z + dz * m5[i].z, h.w + dw * m5[i].w));
      }
    }
  }
}

__device__ __forceinline__ void rmsnorm_rows(const float* src, const float* __restrict__ g, bf16_t* dst) {
  const int lane = threadIdx.x & 63;
  const int wg = blockIdx.x * 4 + (threadIdx.x >> 6), nw = gridDim.x * 4;
  float4 vn[4];
  if (wg < M_) {
#pragma unroll
    for (int i = 0; i < 4; ++i) vn[i] = ((const float4*)(src + (size_t)wg * 1024))[lane + 64 * i];
  }
  for (int row = wg; row < M_; row += nw) {
    float4 v[4];
    float ss = 0.f;
#pragma unroll
    for (int i = 0; i < 4; ++i) v[i] = vn[i];
    if (row + nw < M_) {
#pragma unroll
      for (int i = 0; i < 4; ++i) vn[i] = ((const float4*)(src + (size_t)(row + nw) * 1024))[lane + 64 * i];
    }
#pragma unroll
    for (int i = 0; i < 4; ++i) {
      ss += v[i].x * v[i].x + v[i].y * v[i].y + v[i].z * v[i].z + v[i].w * v[i].w;
    }
    ss = wave_sum(ss);
    float rstd = rsqrtf(ss * (1.0f / 1024.0f) + 1e-6f);
#pragma unroll
    for (int i = 0; i < 4; ++i) {
      float4 gv = make_float4(1.f, 1.f, 1.f, 1.f);
      if (g) gv = ((const float4*)g)[lane + 64 * i];
      uint2 o;
      o.x = pack2(v[i].x * rstd * gv.x, v[i].y * rstd * gv.y);
      o.y = pack2(v[i].z * rstd * gv.z, v[i].w * rstd * gv.w);
      *(uint2*)(dst + (size_t)row * 1024 + (lane + 64 * i) * 4) = o;
    }
  }
}

__device__ __forceinline__ uint32_t mix2(uint32_t c, uint32_t pv, float m0_, float m1_) {
  float c0 = lo_f(c), c1 = hi_f(c), p0 = lo_f(pv), p1 = hi_f(pv);
  return pack2(c0 + (p0 - c0) * m0_, c1 + (p1 - c1) * m1_);
}

struct GemmTile { const bf16_t* A; const bf16_t* BT; int ldb; int NK; int m0; int brow0; };
struct GemmRegs { u32x4 ra[2][4], rb[2][4]; };
#define GEMM_SETUP(t_)                                                                          \
  const int tid = fresh_tid(), lane = tid & 63, w = tid >> 6;                                   \
  const int wr = w >> 1, wc = w & 1;                                                            \
  const int c8 = tid & 7, r32 = tid >> 3;                                                       \
  const int arow0 = (t_).m0 + r32;                                                              \
  const bf16_t* abase = (t_).A + (size_t)arow0 * 1024 + c8 * 8;                                 \
  const int ldb = (t_).ldb;                                                                     \
  const bf16_t* bbase = (t_).BT + (size_t)((t_).brow0 + r32) * ldb + c8 * 8;                    \
  const bool hp0 = (arow0 & (T_ - 1)) != 0;                                                     \
  (void)lane; (void)wr; (void)wc;
#define GLOAD(set_, kt_)                                                                        \
  {                                                                                             \
    const int kt__ = (kt_);                                                                     \
    const bool sh_ = (kt__ >= 16);                                                              \
    const bf16_t* ab_ = abase + (sh_ ? (kt__ - 16) * 64 - 1024 : kt__ * 64);                    \
    _Pragma("unroll") for (int p = 0; p < 4; ++p) {                                             \
      if (p == 0) {                                                                             \
        g.ra[set_][p] = (u32x4)(0u);                                                            \
        if (!sh_ || hp0) g.ra[set_][p] = *(const u32x4*)(ab_);                                  \
      } else g.ra[set_][p] = *(const u32x4*)(ab_ + (size_t)p * 32 * 1024);                      \
      g.rb[set_][p] = *(const u32x4*)(bbase + (size_t)p * 32 * ldb + kt__ * 64);                \
    }                                                                                           \
  }
#define LSTORE(set_, buf_)                                                                      \
  {                                                                                             \
    unsigned char* sA_ = smem + (buf_) * 32768;                                                 \
    unsigned char* sB_ = sA_ + 16384;                                                           \
    _Pragma("unroll") for (int p = 0; p < 4; ++p) {                                             \
      int row = r32 + 32 * p;                                                                   \
      *(u32x4*)(sA_ + sw_off(row, c8)) = g.ra[set_][p];                                         \
      *(u32x4*)(sB_ + sw_off(row, c8)) = g.rb[set_][p];                                         \
    }                                                                                           \
  }
#define KSTEP(buf_)                                                                             \
  {                                                                                             \
    const unsigned char* sA = smem + (buf_) * 32768;                                            \
    const unsigned char* sB = sA + 16384;                                                       \
    _Pragma("unroll") for (int ks = 0; ks < 4; ++ks) {                                          \
      bf16x8 a[2], b[2];                                                                        \
      const int ch = ks * 2 + (lane >> 5);                                                      \
      _Pragma("unroll") for (int i = 0; i < 2; ++i) {                                           \
        a[i] = *(const bf16x8*)(sA + sw_off(64 * wr + 32 * i + (lane & 31), ch));               \
        b[i] = *(const bf16x8*)(sB + sw_off(64 * wc + 32 * i + (lane & 31), ch));               \
      }                                                                                         \
      _Pragma("unroll") for (int i = 0; i < 2; ++i)                                             \
        _Pragma("unroll") for (int j = 0; j < 2; ++j)                                           \
          acc[i][j] = __builtin_amdgcn_mfma_f32_32x32x16_bf16(a[i], b[j], acc[i][j], 0, 0, 0);  \
    }                                                                                           \
  }
__device__ __forceinline__ void gemm_prefetch(const GemmTile& t, GemmRegs& g) {
  GEMM_SETUP(t)
  GLOAD(0, 0);
  GLOAD(1, 1);
}
__device__ __forceinline__ void gemm_main(const GemmTile& t, unsigned char* smem, GemmRegs& g, f32x16 (&acc)[2][2]) {
  GEMM_SETUP(t)
  const int NK = t.NK;
#pragma unroll
  for (int i = 0; i < 2; ++i)
#pragma unroll
    for (int j = 0; j < 2; ++j)
#pragma unroll
      for (int r = 0; r < 16; ++r) acc[i][j][r] = 0.f;
  LSTORE(0, 0);
  __syncthreads();
#pragma unroll 1
  for (int kt = 0; kt < NK; kt += 2) {
    if (kt + 2 < NK) GLOAD(0, kt + 2);
    KSTEP(0);
    LSTORE(1, 1);
    __syncthreads();
    if (kt + 3 < NK) GLOAD(1, kt + 3);
    KSTEP(1);
    if (kt + 2 < NK) LSTORE(0, 0);
    __syncthreads();
  }
}
#undef GLOAD
#undef LSTORE
#undef KSTEP

__device__ __forceinline__ void wave_tile_out(unsigned char* wl, const f32x16 (&acc)[2][2], bf16_t* dst, size_t ld, int lane) {
  const int c = lane & 31, hh = lane >> 5;
#pragma unroll
  for (int mi = 0; mi < 2; ++mi)
#pragma unroll
    for (int ni = 0; ni < 2; ++ni)
#pragma unroll
      for (int r = 0; r < 16; ++r) {
        const int rl = 32 * mi + (r & 3) + 8 * (r >> 2) + 4 * hh;
        *(bf16_t*)(wl + rl * 144 + (32 * ni + c) * 2) = (bf16_t)f2bf(acc[mi][ni][r]);
      }
  __builtin_amdgcn_wave_barrier();
#pragma unroll
  for (int i = 0; i < 8; ++i) {
    const int id = i * 64 + lane, row = id >> 3, ch = id & 7;
    uint4 v = *(const uint4*)(wl + row * 144 + ch * 16);
    *(uint4*)(dst + (size_t)row * ld + ch * 8) = v;
  }
  __builtin_amdgcn_wave_barrier();
}
__device__ __forceinline__ void wave_tile_out_t(unsigned char* wl, const f32x16 (&acc)[2][2], bf16_t* dst, size_t ld, int lane) {
  const int c = lane & 31, hh = lane >> 5;
#pragma unroll
  for (int mi = 0; mi < 2; ++mi)
#pragma unroll
    for (int ni = 0; ni < 2; ++ni)
#pragma unroll
      for (int g = 0; g < 4; ++g) {
        uint2 o;
        o.x = pack2(acc[mi][ni][4 * g + 0], acc[mi][ni][4 * g + 1]);
        o.y = pack2(acc[mi][ni][4 * g + 2], acc[mi][ni][4 * g + 3]);
        *(uint2*)(wl + (32 * ni + c) * 144 + (32 * mi + 8 * g + 4 * hh) * 2) = o;
      }
  __builtin_amdgcn_wave_barrier();
#pragma unroll
  for (int i = 0; i < 8; ++i) {
    const int id = i * 64 + lane, row = id >> 3, ch = id & 7;
    uint4 v = *(const uint4*)(wl + row * 144 + ch * 16);
    *(uint4*)(dst + (size_t)row * ld + ch * 8) = v;
  }
  __builtin_amdgcn_wave_barrier();
}

__device__ __forceinline__ bool xcd_tile(int l, int tn8, int& mt, int& nt) {
  const int xcd = blockIdx.x & 7;
  if (l >= 32 * tn8 * 8) return false;
  const int grp = l >> 6, r = l & 63;
  const int mg = grp / tn8, ng = grp - mg * tn8;
  mt = xcd * 32 + mg * 8 + (r & 7);
  nt = ng * 8 + (r >> 3);
  return true;
}

__device__ __forceinline__ void phase_gemm1(const Params& p, unsigned char* smem) {
  unsigned char* ws = p.ws;
  asm volatile("" : "+s"(ws));
  unsigned char* outb = (unsigned char*)p.out;
  asm volatile("" : "+s"(outb));
  const bf16_t* h0 = (const bf16_t*)(ws + SLOT(1));
  const bf16_t* aR = (const bf16_t*)(ws + SLOT(6));
  const bf16_t* aK = (const bf16_t*)(ws + SLOT(7));
  const bf16_t* aV = (const bf16_t*)outb;
  const bf16_t* aG = (const bf16_t*)(outb + 64 * MB_);
  const bf16_t* WT = (const bf16_t*)(ws + OFF_WT_IN_A);
  const bf16_t* WTS = (const bf16_t*)(ws + OFF_WT_SMALL);
  bf16_t* rbuf = (bf16_t*)(ws + SLOT(2));
  bf16_t* kbuf = (bf16_t*)(ws + SLOT(3));
  bf16_t* vbuf = (bf16_t*)(ws + SLOT(4));
  bf16_t* sgbuf = (bf16_t*)(ws + SLOT(5));
  bf16_t* twdn = (bf16_t*)(ws + OFF_TWDN);
  bf16_t* adn = (bf16_t*)(ws + OFF_ADN);
  const int tid_ = fresh_tid();
  const int lane = tid_ & 63, w = tid_ >> 6, wr = w >> 1, wc = w & 1;
  const int nloc = gridDim.x >> 3;
  const int nmain = (32 * 32 + nloc - 1) / nloc;
  auto find_tile = [&](int& it, int& mt, int& g, GemmTile& td) -> bool {
    for (; it < nmain + 1; ++it) {
      bool ok;
      if (it < nmain) ok = xcd_tile((blockIdx.x >> 3) + it * nloc, 4, mt, g);
      else { ok = (int)blockIdx.x < 256; mt = blockIdx.x; g = 32; }
      if (ok) {
        const int grp = g >> 3, gt = g & 7;
        td.A = grp == 0 ? aR : (grp == 1 ? aK : (grp == 2 ? aV : (grp == 3 ? aG : h0)));
        td.BT = grp == 4 ? WTS : WT;
        td.ldb = grp == 4 ? 2048 : 1024;
        td.NK = grp == 4 ? 32 : 16;
        td.m0 = mt * 128;
        td.brow0 = grp == 4 ? 0 : ((grp == 0 ? 0 : (grp == 1 ? 1088 : (grp == 2 ? 2112 : 3200))) + gt * 128);
        return true;
      }
    }
    return false;
  };
  GemmRegs gr;
  GemmTile cur, nxt;
  int it = 0, mt = 0, g = 0, itn = 0, mtn = 0, gn = 0;
  bool has = find_tile(it, mt, g, cur);
  if (has) gemm_prefetch(cur, gr);
  while (has) {
    f32x16 acc[2][2];
    const int grp = g >> 3, gt = g & 7;
    gemm_main(cur, smem, gr, acc);
    itn = it + 1;
    const bool hn = find_tile(itn, mtn, gn, nxt);
    if (hn) gemm_prefetch(nxt, gr);
    unsigned char* wl = smem + w * 9216;
    if (g < 32) {
      bf16_t* dst = grp == 0 ? rbuf : (grp == 1 ? kbuf : (grp == 2 ? vbuf : sgbuf));
      if (grp == 3) {
#pragma unroll
        for (int mi = 0; mi < 2; ++mi)
#pragma unroll
          for (int ni = 0; ni < 2; ++ni)
#pragma unroll
            for (int r = 0; r < 16; ++r) acc[mi][ni][r] = silu_f(acc[mi][ni][r]);
      }
      wave_tile_out(wl, acc, dst + (size_t)(mt * 128 + 64 * wr) * 1024 + gt * 128 + 64 * wc, 1024, lane);
    } else {
      if (wc == 0) {
#pragma unroll
        for (int mi = 0; mi < 2; ++mi)
#pragma unroll
          for (int ni = 0; ni < 2; ++ni)
#pragma unroll
            for (int r = 0; r < 16; ++r) acc[mi][ni][r] = tanhf(acc[mi][ni][r]);
      }
      wave_tile_out(wl, acc, (wc == 0 ? twdn : adn) + (size_t)(mt * 128 + 64 * wr) * 64, 64, lane);
    }
    __syncthreads();
    cur = nxt; it = itn; mt = mtn; g = gn; has = hn;
  }
}

__device__ __forceinline__ void phase_gemm_res(const bf16_t* A, const bf16_t* WT, const float* res, float* out, unsigned char* smem) {
  asm volatile("" : "+s"(A), "+s"(WT));
  const int tid_ = fresh_tid();
  const int lane = tid_ & 63, w = tid_ >> 6, wr = w >> 1, wc = w & 1;
  const int nloc = gridDim.x >> 3;
  GemmRegs gr;
  GemmTile cur, nxt;
  int l = blockIdx.x >> 3, mt = 0, nt = 0, mtn = 0, ntn = 0;
  bool has = xcd_tile(l, 1, mt, nt);
  if (has) { cur = GemmTile{A, WT, 1024, 16, mt * 128, nt * 128}; gemm_prefetch(cur, gr); }
  while (has) {
    f32x16 acc[2][2];
    gemm_main(cur, smem, gr, acc);
    l += nloc;
    const bool hn = xcd_tile(l, 1, mtn, ntn);
    if (hn) { nxt = GemmTile{A, WT, 1024, 16, mtn * 128, ntn * 128}; gemm_prefetch(nxt, gr); }
#pragma unroll
    for (int mi = 0; mi < 2; ++mi) {
      float rv[2][16];
#pragma unroll
      for (int ni = 0; ni < 2; ++ni)
#pragma unroll
        for (int r = 0; r < 16; ++r) {
          int row = mt * 128 + 64 * wr + 32 * mi + (r & 3) + 8 * (r >> 2) + 4 * (lane >> 5);
          int col = nt * 128 + 64 * wc + 32 * ni + (lane & 31);
          rv[ni][r] = res[(size_t)row * 1024 + col];
        }
#pragma unroll
      for (int ni = 0; ni < 2; ++ni)
#pragma unroll
        for (int r = 0; r < 16; ++r) {
          int row = mt * 128 + 64 * wr + 32 * mi + (r & 3) + 8 * (r >> 2) + 4 * (lane >> 5);
          int col = nt * 128 + 64 * wc + 32 * ni + (lane & 31);
          out[(size_t)row * 1024 + col] = rv[ni][r] + acc[mi][ni][r];
        }
    }
    cur = nxt; mt = mtn; nt = ntn; has = hn;
  }
}

__device__ __forceinline__ void phase_gemm_kvq(const Params& p, unsigned char* smem) {
  unsigned char* ws = p.ws;
  asm volatile("" : "+s"(ws));
  const bf16_t* h1 = (const bf16_t*)(ws + SLOT(1));
  const bf16_t* WT = (const bf16_t*)(ws + OFF_WT_KVQ);
  bf16_t* Kb = (bf16_t*)(ws + SLOT(3));
  bf16_t* Vt = (bf16_t*)(ws + SLOT(4));
  bf16_t* Qb = (bf16_t*)(ws + SLOT(5));
  bf16_t* sgb = (bf16_t*)(ws + SLOT(6));
  const float2* rope = (const float2*)(ws + OFF_ROPE);
  const int tid_ = fresh_tid();
  const int lane = tid_ & 63, w = tid_ >> 6, wr = w >> 1, wc = w & 1;
  const int c = lane & 31, hh = lane >> 5;
  const int nloc = gridDim.x >> 3;
  GemmRegs gr;
  GemmTile cur, nxt;
  int l = blockIdx.x >> 3, mt = 0, nt = 0, mtn = 0, ntn = 0;
  bool has = xcd_tile(l, 4, mt, nt);
  if (has) { cur = GemmTile{h1, WT, 1024, 16, mt * 128, nt * 128}; gemm_prefetch(cur, gr); }
  while (has) {
    const int type = nt >> 3;
    const int head = (nt & 7) * 2 + wc;
    f32x16 acc[2][2];
    gemm_main(cur, smem, gr, acc);
    l += nloc;
    const bool hn = xcd_tile(l, 4, mtn, ntn);
    if (hn) { nxt = GemmTile{h1, WT, 1024, 16, mtn * 128, ntn * 128}; gemm_prefetch(nxt, gr); }
    const int rowbase = mt * 128 + 64 * wr;
    const int b = rowbase >> 13;
    const int t0 = rowbase & (T_ - 1);
    unsigned char* wl = smem + w * 9216;
    if (type == 0 || type == 2) {
      const float* wn = (type == 0) ? p.k_norm : p.q_norm;
      const float osc = (type == 2) ? 0.18033688011112042f : 1.0f;
      const float wn0 = wn[c] * osc, wn1 = wn[32 + c] * osc;
      bf16_t* dst = (type == 0) ? Kb : Qb;
      {
        float2* rl = (float2*)wl;
        float2 rv[8];
#pragma unroll
        for (int j = 0; j < 8; ++j) rv[j] = rope[(size_t)t0 * 8 + lane + 64 * j];
#pragma unroll
        for (int j = 0; j < 8; ++j) rl[lane + 64 * j] = rv[j];
        __builtin_amdgcn_wave_barrier();
      }
#pragma unroll
      for (int mi = 0; mi < 2; ++mi)
#pragma unroll
        for (int r = 0; r < 16; ++r) {
          float v0 = acc[mi][0][r], v1 = acc[mi][1][r];
          float ss = v0 * v0 + v1 * v1;
          ss += dppf<0xB1>(ss);
          ss += dppf<0x4E>(ss);
          ss += dppf<0x141>(ss);
          ss += dppf<0x140>(ss);
          ss += __shfl_xor(ss, 16);
          float rstd = rsqrtf(ss * (1.0f / 64.0f) + 1e-6f);
          v0 = v0 * rstd * wn0;
          v1 = v1 * rstd * wn1;
          const int tl_ = 32 * mi + (r & 3) + 8 * (r >> 2) + 4 * hh;
          float partner = dppf<0x128>(v0);
          {
            float2 cs = ((const float2*)wl)[tl_ * 8 + (c & 7)];
            float rot = (c < 8) ? (v0 * cs.x - partner * cs.y) : (v0 * cs.x + partner * cs.y);
            v0 = (c < 16) ? rot : v0;
          }
          acc[mi][0][r] = v0;
          acc[mi][1][r] = v1;
        }
      if (type == 0) {
        float* kpart = (float*)(ws + OFF_KPART);
#pragma unroll
        for (int ni = 0; ni < 2; ++ni) {
          float cs = 0.f;
#pragma unroll
          for (int mi = 0; mi < 2; ++mi)
#pragma unroll
            for (int r = 0; r < 16; ++r) cs += acc[mi][ni][r];
          cs += __shfl_xor(cs, 32);
          if (hh == 0) kpart[((size_t)((b * 16 + head) * 32 + (t0 >> 8)) * 4 + ((t0 >> 6) & 3)) * 64 + 32 * ni + c] = cs;
        }
      }
      __builtin_amdgcn_wave_barrier();
      wave_tile_out(wl, acc, dst + ((size_t)(b * 16 + head) * T_ + t0) * 64, 64, lane);
    } else if (type == 1) {
      wave_tile_out_t(wl, acc, Vt + (size_t)(b * 16 + head) * 64 * T_ + t0, T_, lane);
    } else {
#pragma unroll
      for (int mi = 0; mi < 2; ++mi)
#pragma unroll
        for (int ni = 0; ni < 2; ++ni)
#pragma unroll
          for (int r = 0; r < 16; ++r) acc[mi][ni][r] = silu_f(acc[mi][ni][r]);
      wave_tile_out(wl, acc, sgb + (size_t)rowbase * 1024 + (nt & 7) * 128 + 64 * wc, 1024, lane);
    }
    __syncthreads();
    cur = nxt; mt = mtn; nt = ntn; has = hn;
  }
}

__device__ __forceinline__ void phase_prep2(const Params& p) {
  unsigned char* ws = p.ws;
  const bf16_t* twdn = (const bf16_t*)(ws + OFF_TWDN);
  const bf16_t* adn = (const bf16_t*)(ws + OFF_ADN);
  const bf16_t* W2T = (const bf16_t*)(ws + OFF_W2T);
  const bf16_t* A2T = (const bf16_t*)(ws + OFF_A2T);
  bf16_t* kbuf = (bf16_t*)(ws + SLOT(3));
  bf16_t* kkbuf = (bf16_t*)(ws + SLOT(1));
  bf16_t* bbuf = (bf16_t*)(ws + SLOT(6));
  bf16_t* rbuf = (bf16_t*)(ws + SLOT(2));
  bf16_t* ebuf = (bf16_t*)p.out;
  float2* scb = (float2*)(ws + OFF_SC);
  const int tid_ = fresh_tid();
  const int lane = tid_ & 63, w = tid_ >> 6;
  const int c = lane & 31, hh = lane >> 5;
  for (int id = blockIdx.x; id < 256 * 16; id += gridDim.x) {
    const int mt = id >> 4, h = id & 15;
    const int row0 = mt * 128 + 32 * w;
    f32x16 aw[2], aa[2];
#pragma unroll
    for (int i = 0; i < 2; ++i)
#pragma unroll
      for (int r = 0; r < 16; ++r) { aw[i][r] = 0.f; aa[i][r] = 0.f; }
#pragma unroll
    for (int ks = 0; ks < 4; ++ks) {
      const int ko = ks * 16 + 8 * hh;
      bf16x8 fw = *(const bf16x8*)(twdn + (size_t)(row0 + c) * 64 + ko);
      bf16x8 fa = *(const bf16x8*)(adn + (size_t)(row0 + c) * 64 + ko);
#pragma unroll
      for (int ni = 0; ni < 2; ++ni) {
        const int n = h * 64 + 32 * ni + c;
        bf16x8 bw = *(const bf16x8*)(W2T + (size_t)n * 64 + ko);
        bf16x8 ba = *(const bf16x8*)(A2T + (size_t)n * 64 + ko);
        aw[ni] = __builtin_amdgcn_mfma_f32_32x32x16_bf16(fw, bw, aw[ni], 0, 0, 0);
        aa[ni] = __builtin_amdgcn_mfma_f32_32x32x16_bf16(fa, ba, aa[ni], 0, 0, 0);
      }
    }
    float w0c[2], a0c[2], kkc[2], kac[2], rkc[2];
#pragma unroll
    for (int ni = 0; ni < 2; ++ni) {
      const int col = h * 64 + 32 * ni + c;
      w0c[ni] = p.w0[col]; a0c[ni] = p.a0[col]; kkc[ni] = p.kk_a[col]; kac[ni] = p.ka_a[col]; rkc[ni] = p.rk_a[col];
    }
#pragma unroll
    for (int rh = 0; rh < 2; ++rh) {
    uint32_t kraw[8][2], rraw[8][2];
#pragma unroll
    for (int r8 = 0; r8 < 8; ++r8) {
      const int r = rh * 8 + r8;
      const int row = row0 + (r & 3) + 8 * (r >> 2) + 4 * hh;
#pragma unroll
      for (int ni = 0; ni < 2; ++ni) {
        const size_t o = (size_t)row * 1024 + h * 64 + 32 * ni + c;
        kraw[r8][ni] = kbuf[o];
        rraw[r8][ni] = rbuf[o];
      }
    }
#pragma unroll
    for (int r8 = 0; r8 < 8; ++r8) {
      const int r = rh * 8 + r8;
      const int row = row0 + (r & 3) + 8 * (r >> 2) + 4 * hh;
      float kr[2], kv[2], rr[2];
#pragma unroll
      for (int ni = 0; ni < 2; ++ni) {
        kr[ni] = bf2f(kraw[r8][ni]);
        rr[ni] = bf2f(rraw[r8][ni]);
        kv[ni] = kr[ni] * kkc[ni];
      }
      float ss = half_sum(kv[0] * kv[0] + kv[1] * kv[1]);
      float inv = 1.0f / fmaxf(sqrtf(ss), 1e-12f);
      float decv[2], kkr[2];
      float pbr = 0.f, pc1 = 0.f, pc2 = 0.f;
#pragma unroll
      for (int ni = 0; ni < 2; ++ni) {
        const size_t o = (size_t)row * 1024 + h * 64 + 32 * ni + c;
        float z = w0c[ni] + aw[ni][r];
        float u = -z;
        float sp = fmaxf(u, 0.f) + log1pf(expf(-fabsf(u)));
        float wl = -sp - 0.5f;
        float e = expf(wl);
        float a = 1.0f / (1.0f + expf(-(a0c[ni] + aa[ni][r])));
        float kkn = kv[ni] * inv;
        float k2 = kr[ni] * (1.0f + (a - 1.0f) * kac[ni]);
        const uint32_t ue = f2bf(e), uk2 = f2bf(k2), ukk = f2bf(kkn), ub = f2bf(kkn * a);
        ebuf[o] = (bf16_t)ue;
        kbuf[o] = (bf16_t)uk2;
        kkbuf[o] = (bf16_t)ukk;
        bbuf[o] = (bf16_t)ub;
        const float k2r = bf2f(uk2), br_ = bf2f(ub);
        pbr = fmaf(br_, rr[ni], pbr);
        pc1 = fmaf(k2r, rr[ni], pc1);
        pc2 = fmaf(rr[ni] * k2r, rkc[ni], pc2);
        decv[ni] = expf(-bf2f(ue));
        kkr[ni] = bf2f(ukk);
      }
      pbr = half_sum(pbr); pc1 = half_sum(pc1); pc2 = half_sum(pc2);
#pragma unroll
      for (int ni = 0; ni < 2; ++ni) {
        const size_t o = (size_t)row * 1024 + h * 64 + 32 * ni + c;
        rbuf[o] = (bf16_t)f2bf(decv[ni] * rr[ni] - kkr[ni] * pbr);
      }
      if (c == 0) scb[(size_t)row * 16 + h] = make_float2(pc1, pc2);
    }
    }
  }
}

#define SCAN_SLOC(p) ((float*)((unsigned char*)(p).out + 64 * MB_))
#define SCAN_P(p) ((float*)((unsigned char*)(p).out + 96 * MB_))

__device__ __forceinline__ void phase_scan2(const Params& p, unsigned char* smem) {
  float* Pl = (float*)smem;
  float* St = Pl + 64 * 64;
  float* Sloc = SCAN_SLOC(p);
  const float* Pm = SCAN_P(p);
  const int tid = threadIdx.x;
  const int vl = tid >> 4, kq = tid & 15;
  if (gridDim.x >= 512 && blockIdx.x >= 256) {
    float* tl = (float*)smem;
    unsigned char* ws = p.ws;
    for (int j = 1312 + ((int)blockIdx.x - 256); j < 2592; j += (int)gridDim.x - 256) {
      if (j < 1824) transpose_job(p.w_kv, 2048, 1024, (bf16_t*)(ws + OFF_WT_KVQ), p.norm_kv, j - 1312, tl);
      else if (j < 2336) transpose_job(p.w_in_b, 2048, 1024, (bf16_t*)(ws + OFF_WT_KVQ) + (size_t)2048 * 1024, p.norm_b, j - 1824, tl);
      else transpose_job(p.w_out_b, 1024, 1024, (bf16_t*)(ws + OFF_WT_OUT_B), nullptr, j - 2336, tl);
    }
  }
  for (int unit = blockIdx.x; unit < 256; unit += gridDim.x) {
    const int bh = unit >> 2, rg4 = unit & 3;
    const int v = rg4 * 16 + vl;
    __syncthreads();
    *(f32x4*)(St + vl * 68 + 4 * kq) = (f32x4){0.f, 0.f, 0.f, 0.f};
    f32x4 pn[4], sn;
    {
      const f32x4* Pg = (const f32x4*)(Pm + (size_t)(bh * NC_) * 4096);
#pragma unroll
      for (int i = 0; i < 4; ++i) pn[i] = Pg[tid + 256 * i];
      sn = *(const f32x4*)(Sloc + (size_t)(bh * NC_) * 4096 + v * 64 + 4 * kq);
    }
    for (int cidx = 0; cidx < NC_ - 1; ++cidx) {
      __syncthreads();
#pragma unroll
      for (int i = 0; i < 4; ++i) ((f32x4*)Pl)[tid + 256 * i] = pn[i];
      f32x4 acc = sn;
      float* Sg = Sloc + (size_t)(bh * NC_ + cidx) * 4096 + v * 64 + 4 * kq;
      if (cidx + 1 < NC_ - 1) {
        const f32x4* Pg = (const f32x4*)(Pm + (size_t)(bh * NC_ + cidx + 1) * 4096);
#pragma unroll
        for (int i = 0; i < 4; ++i) pn[i] = Pg[tid + 256 * i];
        sn = *(const f32x4*)(Sg + 4096);
      }
      __syncthreads();
      f32x4 a0 = acc, a1 = (f32x4){0.f, 0.f, 0.f, 0.f};
#pragma unroll 8
      for (int j = 0; j < 64; j += 2) {
        const float s0 = St[vl * 68 + j], s1 = St[vl * 68 + j + 1];
        const f32x4 p0 = *(const f32x4*)(Pl + j * 64 + 4 * kq);
        const f32x4 p1 = *(const f32x4*)(Pl + (j + 1) * 64 + 4 * kq);
        a0 = p0 * s0 + a0;
        a1 = p1 * s1 + a1;
      }
      acc = a0 + a1;
      __syncthreads();
      *(f32x4*)(St + vl * 68 + 4 * kq) = acc;
      *(f32x4*)Sg = acc;
    }
  }
}

#define M3_WAVE_BYTES 16640
#define M3_XT 0
#define M3_W 4096
#define M3_WT 8192
#define M3_Z 12288
#define M3_G 16384
template <int T>
__device__ __forceinline__ void m3_recur(const float* zt, const float (&D)[32], const float (&vs)[16], float (&sav)[16], float (&yv)[16]) {
  float sa = D[T], y = D[16 + T];
  if constexpr (T > 0) {
    constexpr int NQ = (T + 3) / 4;
#pragma unroll
    for (int q = 0; q < NQ; ++q) {
      const f32x4 a4 = *(const f32x4*)(zt + T * 32 + 4 * q);
      const f32x4 b4 = *(const f32x4*)(zt + T * 32 + 16 + 4 * q);
      const f32x4 c4 = *(const f32x4*)(zt + (16 + T) * 32 + 4 * q);
      const f32x4 e4 = *(const f32x4*)(zt + (16 + T) * 32 + 16 + 4 * q);
#pragma unroll
      for (int i = 0; i < 4; ++i) {
        const int s_ = 4 * q + i;
        if (s_ < T) {
          sa = fmaf(vs[s_], a4[i], sa); sa = fmaf(-sav[s_], b4[i], sa);
          y = fmaf(vs[s_], c4[i], y); y = fmaf(-sav[s_], e4[i], y);
        }
      }
    }
  }
  sav[T] = sa;
  yv[T] = y;
  if constexpr (T + 1 < 16) m3_recur<T + 1>(zt, D, vs, sav, yv);
}

__device__ __forceinline__ void phase_scan3_mfma(const Params& p, unsigned char* smem) {
  const int lane = threadIdx.x & 63, w = __builtin_amdgcn_readfirstlane(threadIdx.x >> 6);
  const int c = lane & 31, hh = lane >> 5;
  unsigned char* wl = smem + w * M3_WAVE_BYTES;
  unsigned char* ws = p.ws;
  const float* Sst = SCAN_SLOC(p);
  const bf16_t* kkb = (const bf16_t*)(ws + SLOT(1));
  const bf16_t* rb = (const bf16_t*)(ws + SLOT(2));
  const bf16_t* kb = (const bf16_t*)(ws + SLOT(3));
  const bf16_t* vb = (const bf16_t*)(ws + SLOT(4));
  const bf16_t* sgb = (const bf16_t*)(ws + SLOT(5));
  const bf16_t* bb = (const bf16_t*)(ws + SLOT(6));
  const bf16_t* eb = (const bf16_t*)p.out;
  const float2* scb = (const float2*)(ws + OFF_SC);
  bf16_t* yg = (bf16_t*)(ws + SLOT(7));
  const int wg = blockIdx.x * 4 + w, nw = gridDim.x * 4;
  for (int unit = wg; unit < 64 * NC_; unit += nw) {
    const int bh = unit / NC_, cidx = unit - bh * NC_;
    const int b = bh >> 4, h = bh & 15;
    f32x16 H[2][2];
#pragma unroll
    for (int kt = 0; kt < 2; ++kt)
#pragma unroll
      for (int vt = 0; vt < 2; ++vt) {
#pragma unroll
        for (int g = 0; g < 4; ++g) {
          f32x4 t = {0.f, 0.f, 0.f, 0.f};
          if (cidx != 0) t = *(const f32x4*)(Sst + ((size_t)(bh * NC_ + cidx - 1) * 64 + (c + 32 * vt)) * 64 + 32 * kt + 8 * g + 4 * hh);
          H[kt][vt][4 * g + 0] = t.x; H[kt][vt][4 * g + 1] = t.y; H[kt][vt][4 * g + 2] = t.z; H[kt][vt][4 * g + 3] = t.w;
        }
      }
    const float gw = p.gn_w[h * 64 + lane], gb = p.gn_b[h * 64 + lane];
    const int row0 = b * T_ + cidx * CL_;
    const size_t base = (size_t)row0 * 1024 + h * 64 + lane;
#pragma unroll 1
    for (int stg = 0; stg < CL_ / 16; ++stg) {
      const int step0 = stg * 16;
      float G = 1.0f;
      uint32_t kbits[16], bbits[16];
      uint32_t rkk[16], re[16], rbv[16], rkv[16], rrv[16], rvv[16], rsg[16];
#pragma unroll
      for (int i = 0; i < 16; ++i) {
        const size_t o = base + (size_t)(step0 + i) * 1024;
        rkk[i] = kkb[o]; re[i] = eb[o]; rbv[i] = bb[o]; rkv[i] = kb[o]; rrv[i] = rb[o]; rvv[i] = vb[o]; rsg[i] = sgb[o];
      }
      const float2 cc = scb[(size_t)(row0 + step0 + (lane & 15)) * 16 + h];
#pragma unroll
      for (int s_ = 0; s_ < 16; ++s_) {
        const float kkt = bf2f(rkk[s_]) * G, rt = bf2f(rrv[s_]) * G;
        G *= __expf(-bf2f(re[s_]));
        const float iG = __builtin_amdgcn_rcpf(G);
        kbits[s_] = f2bf(bf2f(rkv[s_]) * iG);
        bbits[s_] = f2bf(bf2f(rbv[s_]) * iG);
        const int co = (lane & 7) * 2, ch = lane >> 3;
        *(bf16_t*)(wl + M3_XT + sw_off(s_, ch) + co) = (bf16_t)f2bf(kkt);
        *(bf16_t*)(wl + M3_XT + sw_off(16 + s_, ch) + co) = (bf16_t)f2bf(rt);
        *(bf16_t*)(wl + M3_W + sw_off(s_, ch) + co) = (bf16_t)kbits[s_];
        *(bf16_t*)(wl + M3_W + sw_off(16 + s_, ch) + co) = (bf16_t)bbits[s_];
      }
      {
        uint4* wr_ = (uint4*)(wl + M3_WT + lane * 64);
        wr_[0] = make_uint4(kbits[0] | (kbits[1] << 16), kbits[2] | (kbits[3] << 16), kbits[4] | (kbits[5] << 16), kbits[6] | (kbits[7] << 16));
        wr_[1] = make_uint4(kbits[8] | (kbits[9] << 16), kbits[10] | (kbits[11] << 16), kbits[12] | (kbits[13] << 16), kbits[14] | (kbits[15] << 16));
        wr_[2] = make_uint4(bbits[0] | (bbits[1] << 16), bbits[2] | (bbits[3] << 16), bbits[4] | (bbits[5] << 16), bbits[6] | (bbits[7] << 16));
        wr_[3] = make_uint4(bbits[8] | (bbits[9] << 16), bbits[10] | (bbits[11] << 16), bbits[12] | (bbits[13] << 16), bbits[14] | (bbits[15] << 16));
        ((float*)(wl + M3_G))[lane] = G;
      }
      float vs[16], sgs[16];
#pragma unroll
      for (int i = 0; i < 16; ++i) {
        vs[i] = bf2f(rvv[i]);
        sgs[i] = bf2f(rsg[i]);
      }
      __builtin_amdgcn_wave_barrier();
      {
        f32x16 z;
#pragma unroll
        for (int r = 0; r < 16; ++r) z[r] = 0.f;
#pragma unroll
        for (int ks = 0; ks < 4; ++ks) {
          const bf16x8 a = *(const bf16x8*)(wl + M3_W + sw_off(c, 2 * ks + hh));
          const bf16x8 bq = *(const bf16x8*)(wl + M3_XT + sw_off(c, 2 * ks + hh));
          z = __builtin_amdgcn_mfma_f32_32x32x16_bf16(a, bq, z, 0, 0, 0);
        }
        float* zt = (float*)(wl + M3_Z);
#pragma unroll
        for (int g = 0; g < 4; ++g)
          *(f32x4*)(zt + c * 32 + 8 * g + 4 * hh) = (f32x4){z[4 * g], z[4 * g + 1], z[4 * g + 2], z[4 * g + 3]};
      }
      f32x16 DT[2];
#pragma unroll
      for (int vt = 0; vt < 2; ++vt) {
#pragma unroll
        for (int r = 0; r < 16; ++r) DT[vt][r] = 0.f;
#pragma unroll
        for (int kt = 0; kt < 2; ++kt)
#pragma unroll
          for (int sp = 0; sp < 2; ++sp) {
            union { uint32_t u[4]; bf16x8 v; } hb;
#pragma unroll
            for (int jj = 0; jj < 4; ++jj) hb.u[jj] = pack2(H[kt][vt][8 * sp + 2 * jj], H[kt][vt][8 * sp + 2 * jj + 1]);
            union { uint2 u[2]; bf16x8 v; } xa;
            xa.u[0] = *(const uint2*)(wl + M3_XT + sw_off(c, 4 * kt + 2 * sp) + 8 * hh);
            xa.u[1] = *(const uint2*)(wl + M3_XT + sw_off(c, 4 * kt + 2 * sp + 1) + 8 * hh);
            DT[vt] = __builtin_amdgcn_mfma_f32_32x32x16_bf16(xa.v, hb.v, DT[vt], 0, 0, 0);
          }
      }
      float D[32];
      {
        float own[16], rcv[16];
#pragma unroll
        for (int r = 0; r < 16; ++r) {
          own[r] = hh ? DT[1][r] : DT[0][r];
          const float snd = hh ? DT[0][r] : DT[1][r];
          rcv[r] = __shfl_xor(snd, 32);
        }
#pragma unroll
        for (int t = 0; t < 32; ++t) {
          const int r = (t & 3) + 4 * (t >> 3);
          const int hs = (t >> 2) & 1;
          D[t] = (hs == hh) ? own[r] : rcv[r];
        }
      }
      float sav[16], yv[16];
      __builtin_amdgcn_wave_barrier();
      m3_recur<0>((const float*)(wl + M3_Z), D, vs, sav, yv);
      {
        float* yb = (float*)(wl + M3_XT);
        float* stt = (float*)(wl + M3_Z);
        float yt[16];
#pragma unroll
        for (int t = 0; t < 16; ++t) {
          const float c1 = __int_as_float(__builtin_amdgcn_readlane(__float_as_int(cc.x), t));
          yt[t] = yv[t] + vs[t] * c1;
          yb[t * 64 + lane] = yt[t];
        }
        __builtin_amdgcn_wave_barrier();
        {
          const int tt = lane >> 2, q4 = lane & 3;
          float a1 = 0.f, a2 = 0.f;
#pragma unroll
          for (int i = 0; i < 4; ++i) {
            const f32x4 y4 = *(const f32x4*)(yb + tt * 64 + q4 * 16 + 4 * i);
            a1 += (y4.x + y4.y) + (y4.z + y4.w);
            a2 += (y4.x * y4.x + y4.y * y4.y) + (y4.z * y4.z + y4.w * y4.w);
          }
          a1 += dppf<0xB1>(a1); a1 += dppf<0x4E>(a1);
          a2 += dppf<0xB1>(a2); a2 += dppf<0x4E>(a2);
          if (q4 == 0) *(float2*)(stt + 2 * tt) = make_float2(a1 * (1.0f / 64.0f), a2 * (1.0f / 64.0f));
        }
        __builtin_amdgcn_wave_barrier();
#pragma unroll
        for (int t = 0; t < 16; ++t) {
          const float2 ms = *(const float2*)(stt + 2 * t);
          const float c2 = __int_as_float(__builtin_amdgcn_readlane(__float_as_int(cc.y), t));
          const float var = fmaxf(ms.y - ms.x * ms.x, 0.f);
          const float yn = (yt[t] - ms.x) * rsqrtf(var + 64e-5f) * gw + gb;
          const float o = (yn + c2 * vs[t]) * sgs[t];
          yg[base + (size_t)(step0 + t) * 1024] = (bf16_t)f2bf(o);
        }
      }
      {
        float ownv[8], owns[8], rcvv[8], rcvs[8];
#pragma unroll
        for (int jj = 0; jj < 8; ++jj) {
          ownv[jj] = hh ? vs[8 + jj] : vs[jj];
          owns[jj] = hh ? sav[8 + jj] : sav[jj];
          const float sv = hh ? vs[jj] : vs[8 + jj];
          const float ss = hh ? sav[jj] : sav[8 + jj];
          rcvv[jj] = __shfl_xor(sv, 32);
          rcvs[jj] = __shfl_xor(ss, 32);
        }
#pragma unroll
        for (int vt = 0; vt < 2; ++vt) {
          union { uint32_t u[4]; bf16x8 v; } bv, bs;
#pragma unroll
          for (int q = 0; q < 4; ++q) {
            const float v0 = (hh == vt) ? ownv[2 * q] : rcvv[2 * q], v1 = (hh == vt) ? ownv[2 * q + 1] : rcvv[2 * q + 1];
            const float s0 = (hh == vt) ? owns[2 * q] : rcvs[2 * q], s1_ = (hh == vt) ? owns[2 * q + 1] : rcvs[2 * q + 1];
            bv.u[q] = pack2(v0, v1);
            bs.u[q] = pack2(-s0, -s1_);
          }
#pragma unroll
          for (int kt = 0; kt < 2; ++kt) {
            const bf16x8 a0 = *(const bf16x8*)(wl + M3_WT + (c + 32 * kt) * 64 + 16 * hh);
            const bf16x8 a1 = *(const bf16x8*)(wl + M3_WT + (c + 32 * kt) * 64 + 32 + 16 * hh);
            H[kt][vt] = __builtin_amdgcn_mfma_f32_32x32x16_bf16(a0, bv.v, H[kt][vt], 0, 0, 0);
            H[kt][vt] = __builtin_amdgcn_mfma_f32_32x32x16_bf16(a1, bs.v, H[kt][vt], 0, 0, 0);
          }
        }
      }
#pragma unroll
      for (int kt = 0; kt < 2; ++kt)
#pragma unroll
        for (int g = 0; g < 4; ++g) {
          const f32x4 gq = *(const f32x4*)((const float*)(wl + M3_G) + 32 * kt + 8 * g + 4 * hh);
#pragma unroll
          for (int vt = 0; vt < 2; ++vt) {
            H[kt][vt][4 * g + 0] *= gq.x; H[kt][vt][4 * g + 1] *= gq.y; H[kt][vt][4 * g + 2] *= gq.z; H[kt][vt][4 * g + 3] *= gq.w;
          }
        }
      __builtin_amdgcn_wave_barrier();
    }
  }
}

template <int T>
__device__ __forceinline__ void m1_recur(const float* zt, float (&D)[16], float (&Dp)[16], const float (&vs)[16]) {
  float sa = D[T], sp = Dp[T];
  if constexpr (T > 0) {
    constexpr int NQ = (T + 3) / 4;
#pragma unroll
    for (int q = 0; q < NQ; ++q) {
      const f32x4 a4 = *(const f32x4*)(zt + T * 32 + 4 * q);
      const f32x4 b4 = *(const f32x4*)(zt + T * 32 + 16 + 4 * q);
#pragma unroll
      for (int i = 0; i < 4; ++i) {
        const int s_ = 4 * q + i;
        if (s_ < T) {
          sa = fmaf(vs[s_], a4[i], sa); sa = fmaf(-D[s_], b4[i], sa);
          sp = fmaf(-Dp[s_], b4[i], sp);
        }
      }
    }
  }
  D[T] = sa;
  Dp[T] = sp;
  if constexpr (T + 1 < 16) m1_recur<T + 1>(zt, D, Dp, vs);
}
__device__ __forceinline__ void m1_dots(const unsigned char* wl, const f32x16 (&H)[2][2], int c, int hh, float (&D)[16]) {
  f32x16 DT[2];
#pragma unroll
  for (int vt = 0; vt < 2; ++vt) {
#pragma unroll
    for (int r = 0; r < 16; ++r) DT[vt][r] = 0.f;
#pragma unroll
    for (int kt = 0; kt < 2; ++kt)
#pragma unroll
      for (int sp = 0; sp < 2; ++sp) {
        union { uint32_t u[4]; bf16x8 v; } hb;
#pragma unroll
        for (int jj = 0; jj < 4; ++jj) hb.u[jj] = pack2(H[kt][vt][8 * sp + 2 * jj], H[kt][vt][8 * sp + 2 * jj + 1]);
        union { uint2 u[2]; bf16x8 v; } xa;
        xa.u[0] = *(const uint2*)(wl + M3_XT + sw_off(c, 4 * kt + 2 * sp) + 8 * hh);
        xa.u[1] = *(const uint2*)(wl + M3_XT + sw_off(c, 4 * kt + 2 * sp + 1) + 8 * hh);
        DT[vt] = __builtin_amdgcn_mfma_f32_32x32x16_bf16(xa.v, hb.v, DT[vt], 0, 0, 0);
      }
  }
  float own[8], rcv[8];
#pragma unroll
  for (int r = 0; r < 8; ++r) {
    own[r] = hh ? DT[1][r] : DT[0][r];
    const float snd = hh ? DT[0][r] : DT[1][r];
    rcv[r] = __shfl_xor(snd, 32);
  }
#pragma unroll
  for (int t = 0; t < 16; ++t) {
    const int r = (t & 3) + 4 * (t >> 3);
    const int hs = (t >> 2) & 1;
    D[t] = (hs == hh) ? own[r] : rcv[r];
  }
}
template <bool NEG>
__device__ __forceinline__ void m1_update(const unsigned char* wl, f32x16 (&H)[2][2], const float (&vals)[16], int jbyte, int c, int hh) {
  float own[8], rcv[8];
#pragma unroll
  for (int jj = 0; jj < 8; ++jj) {
    own[jj] = hh ? vals[8 + jj] : vals[jj];
    const float sv = hh ? vals[jj] : vals[8 + jj];
    rcv[jj] = __shfl_xor(sv, 32);
  }
#pragma unroll
  for (int vt = 0; vt < 2; ++vt) {
    union { uint32_t u[4]; bf16x8 v; } bv;
#pragma unroll
    for (int q = 0; q < 4; ++q) {
      const float v0 = (hh == vt) ? own[2 * q] : rcv[2 * q], v1 = (hh == vt) ? own[2 * q + 1] : rcv[2 * q + 1];
      bv.u[q] = NEG ? pack2(-v0, -v1) : pack2(v0, v1);
    }
#pragma unroll
    for (int kt = 0; kt < 2; ++kt) {
      const bf16x8 a0 = *(const bf16x8*)(wl + M3_WT + (c + 32 * kt) * 64 + jbyte + 16 * hh);
      H[kt][vt] = __builtin_amdgcn_mfma_f32_32x32x16_bf16(a0, bv.v, H[kt][vt], 0, 0, 0);
    }
  }
}
__device__ __forceinline__ void m1_rescale(const unsigned char* wl, f32x16 (&H)[2][2], int hh) {
#pragma unroll
  for (int kt = 0; kt < 2; ++kt)
#pragma unroll
    for (int g = 0; g < 4; ++g) {
      const f32x4 gq = *(const f32x4*)((const float*)(wl + M3_G) + 32 * kt + 8 * g + 4 * hh);
#pragma unroll
      for (int vt = 0; vt < 2; ++vt) {
        H[kt][vt][4 * g + 0] *= gq.x; H[kt][vt][4 * g + 1] *= gq.y; H[kt][vt][4 * g + 2] *= gq.z; H[kt][vt][4 * g + 3] *= gq.w;
      }
    }
}

template <int T, bool ISP>
__device__ __forceinline__ void m1_recur1(const float* zt, float (&D)[16], const float (&vs)[16]) {
  float sa = D[T];
  if constexpr (T > 0) {
    constexpr int NQ = (T + 3) / 4;
#pragma unroll
    for (int q = 0; q < NQ; ++q) {
      f32x4 a4 = {0.f, 0.f, 0.f, 0.f};
      if (!ISP) a4 = *(const f32x4*)(zt + T * 32 + 4 * q);
      const f32x4 b4 = *(const f32x4*)(zt + T * 32 + 16 + 4 * q);
#pragma unroll
      for (int i = 0; i < 4; ++i) {
        const int s_ = 4 * q + i;
        if (s_ < T) {
          if (!ISP) sa = fmaf(vs[s_], a4[i], sa);
          sa = fmaf(-D[s_], b4[i], sa);
        }
      }
    }
  }
  D[T] = sa;
  if constexpr (T + 1 < 16) m1_recur1<T + 1, ISP>(zt, D, vs);
}

template <bool ISP>
__device__ __forceinline__ void scan1_unit(const Params& p, unsigned char* wl, int bh, int cidx, int lane) {
  const int c = lane & 31, hh = lane >> 5;
  unsigned char* ws = p.ws;
  float* dstbuf = ISP ? SCAN_P(p) : SCAN_SLOC(p);
  const bf16_t* kkb = (const bf16_t*)(ws + SLOT(1));
  const bf16_t* kb = (const bf16_t*)(ws + SLOT(3));
  const bf16_t* vb = (const bf16_t*)(ws + SLOT(4));
  const bf16_t* bb = (const bf16_t*)(ws + SLOT(6));
  const bf16_t* eb = (const bf16_t*)p.out;
  const int b = bh >> 4, h = bh & 15;
  f32x16 H[2][2];
  int cl = c, hl = hh;
  asm volatile("" : "+v"(cl), "+v"(hl));
#pragma unroll
  for (int kt = 0; kt < 2; ++kt)
#pragma unroll
    for (int vt = 0; vt < 2; ++vt)
#pragma unroll
      for (int r = 0; r < 16; ++r)
        H[kt][vt][r] = (ISP && ((32 * kt + (r & 3) + 8 * (r >> 2) + 4 * hl) == (cl + 32 * vt))) ? 1.f : 0.f;
  const int row0 = b * T_ + cidx * CL_;
  const size_t base = (size_t)row0 * 1024 + h * 64 + lane;
  uint32_t rkk[16], re[16], rbv[16], rkv[16];
#pragma unroll
  for (int i = 0; i < 16; ++i) {
    const size_t o = base + (size_t)i * 1024;
    rkk[i] = kkb[o]; re[i] = eb[o]; rbv[i] = bb[o];
    if (!ISP) rkv[i] = kb[o];
  }
#pragma unroll 1
  for (int stg = 0; stg < CL_ / 16; ++stg) {
    const int step0 = stg * 16;
    float G = 1.0f;
    uint32_t rvv[16];
    if (!ISP) {
#pragma unroll
      for (int i = 0; i < 16; ++i) rvv[i] = vb[base + (size_t)(step0 + i) * 1024];
    }
    {
#pragma unroll
      for (int s_ = 0; s_ < 16; ++s_) {
        const float kkt = bf2f(rkk[s_]) * G;
        G *= __expf(-bf2f(re[s_]));
        const float iG = __builtin_amdgcn_rcpf(G);
        const uint32_t bbit = f2bf(bf2f(rbv[s_]) * iG);
        const int co = (lane & 7) * 2, ch = lane >> 3;
        *(bf16_t*)(wl + M3_XT + sw_off(s_, ch) + co) = (bf16_t)f2bf(kkt);
        *(bf16_t*)(wl + M3_W + sw_off(16 + s_, ch) + co) = (bf16_t)bbit;
        *(bf16_t*)(wl + M3_WT + lane * 64 + 32 + s_ * 2) = (bf16_t)bbit;
        if (!ISP) {
          const uint32_t kbit = f2bf(bf2f(rkv[s_]) * iG);
          *(bf16_t*)(wl + M3_W + sw_off(s_, ch) + co) = (bf16_t)kbit;
          *(bf16_t*)(wl + M3_WT + lane * 64 + s_ * 2) = (bf16_t)kbit;
        }
      }
      ((float*)(wl + M3_G))[lane] = G;
    }
    if (stg + 1 < CL_ / 16) {
#pragma unroll
      for (int i = 0; i < 16; ++i) {
        const size_t o = base + (size_t)(step0 + 16 + i) * 1024;
        rkk[i] = kkb[o]; re[i] = eb[o]; rbv[i] = bb[o];
        if (!ISP) rkv[i] = kb[o];
      }
    }
    __builtin_amdgcn_wave_barrier();
    {
      f32x16 z;
#pragma unroll
      for (int r = 0; r < 16; ++r) z[r] = 0.f;
#pragma unroll
      for (int ks = 0; ks < 4; ++ks) {
        const bf16x8 a = *(const bf16x8*)(wl + M3_W + sw_off(c, 2 * ks + hh));
        const bf16x8 bq = *(const bf16x8*)(wl + M3_XT + sw_off(c, 2 * ks + hh));
        z = __builtin_amdgcn_mfma_f32_32x32x16_bf16(a, bq, z, 0, 0, 0);
      }
      float* zt = (float*)(wl + M3_Z);
#pragma unroll
      for (int g = 0; g < 4; ++g)
        *(f32x4*)(zt + c * 32 + 8 * g + 4 * hh) = (f32x4){z[4 * g], z[4 * g + 1], z[4 * g + 2], z[4 * g + 3]};
    }
    float D[16];
    m1_dots(wl, H, c, hh, D);
    float vs[16];
#pragma unroll
    for (int i = 0; i < 16; ++i) vs[i] = ISP ? 0.f : bf2f(rvv[i]);
    __builtin_amdgcn_wave_barrier();
    m1_recur1<0, ISP>((const float*)(wl + M3_Z), D, vs);
    if (!ISP) m1_update<false>(wl, H, vs, 0, c, hh);
    m1_update<true>(wl, H, D, 32, c, hh);
    m1_rescale(wl, H, hh);
    __builtin_amdgcn_wave_barrier();
  }
#pragma unroll
  for (int kt = 0; kt < 2; ++kt)
#pragma unroll
    for (int vt = 0; vt < 2; ++vt)
#pragma unroll
      for (int g = 0; g < 4; ++g) {
        const size_t o = ((size_t)(bh * NC_ + cidx) * 64 + (c + 32 * vt)) * 64 + 32 * kt + 8 * g + 4 * hh;
        *(f32x4*)(dstbuf + o) = (f32x4){H[kt][vt][4 * g], H[kt][vt][4 * g + 1], H[kt][vt][4 * g + 2], H[kt][vt][4 * g + 3]};
      }
}

__device__ __forceinline__ void phase_scan1_mfma(const Params& p, unsigned char* smem) {
  const int lane = threadIdx.x & 63, w = __builtin_amdgcn_readfirstlane(threadIdx.x >> 6);
  unsigned char* wl = smem + w * M3_WAVE_BYTES;
  const int wg = blockIdx.x * 4 + w, nw = gridDim.x * 4;
  for (int u = wg; u < 2 * 64 * (NC_ - 1); u += nw) {
    const int unit = u >> 1;
    const int bh = unit / (NC_ - 1), cidx = unit - bh * (NC_ - 1);
    if (u & 1) scan1_unit<true>(p, wl, bh, cidx, lane);
    else scan1_unit<false>(p, wl, bh, cidx, lane);
  }
}

__device__ __forceinline__ unsigned char* opart_region(unsigned char* ws, int j, int b) {
  if (j == 0) return ws + SLOT(1) + (size_t)b * 16 * MB_;
  if (j == 1) return ws + SLOT(2) + (size_t)b * 16 * MB_;
  if (b < 3) return ws + SLOT(7) + (size_t)(b + 1) * 16 * MB_;
  return ws + OFF_P;
}

__device__ __forceinline__ void phase_gate(const Params& p, unsigned char* smem) {
  const bf16_t* Qb = (const bf16_t*)(p.ws + SLOT(5));
  const float* kpart = (const float*)(p.ws + OFF_KPART);
  uint32_t* sel = (uint32_t*)(p.ws + OFF_SEL);
  float* km = (float*)smem;
  const int tid = fresh_tid();
  for (int unit = blockIdx.x; unit < 64 * 32; unit += gridDim.x) {
    const int bh = unit >> 5, cb = unit & 31;
    __syncthreads();
    for (int i = tid; i < cb * 64; i += NTHREADS) {
      const float* kp = kpart + ((size_t)(bh * 32 + (i >> 6)) * 4) * 64 + (i & 63);
      km[i] = ((kp[0] + kp[64]) + (kp[128] + kp[192])) * (1.0f / 256.0f);
    }
    __syncthreads();
    const int t = cb * 256 + tid;
    const uint4* qp = (const uint4*)(Qb + ((size_t)bh * T_ + t) * 64);
    float q[64];
#pragma unroll
    for (int i = 0; i < 8; ++i) {
      uint4 u = qp[i];
      q[8 * i + 0] = lo_f(u.x); q[8 * i + 1] = hi_f(u.x); q[8 * i + 2] = lo_f(u.y); q[8 * i + 3] = hi_f(u.y);
      q[8 * i + 4] = lo_f(u.z); q[8 * i + 5] = hi_f(u.z); q[8 * i + 6] = lo_f(u.w); q[8 * i + 7] = hi_f(u.w);
    }
    float b0 = -3e38f, b1 = -3e38f, b2 = -3e38f;
    int i0 = 255, i1 = 255, i2 = 255;
    for (int n = 0; n < cb; ++n) {
      const float4* kp = (const float4*)(km + n * 64);
      float s0 = 0.f, s1 = 0.f;
#pragma unroll
      for (int i = 0; i < 16; ++i) {
        float4 kv = kp[i];
        s0 = fmaf(q[4 * i], kv.x, s0); s1 = fmaf(q[4 * i + 1], kv.y, s1);
        s0 = fmaf(q[4 * i + 2], kv.z, s0); s1 = fmaf(q[4 * i + 3], kv.w, s1);
      }
      const float s = s0 + s1;
      if (s > b0) { b2 = b1; i2 = i1; b1 = b0; i1 = i0; b0 = s; i0 = n; }
      else if (s > b1) { b2 = b1; i2 = i1; b1 = s; i1 = n; }
      else if (s > b2) { b2 = s; i2 = n; }
    }
    sel[(size_t)bh * T_ + t] = (uint32_t)i0 | ((uint32_t)i1 << 8) | ((uint32_t)i2 << 16);
  }
}

__device__ __forceinline__ int list_off(int n) { return n * T_ - 128 * n * (n + 1); }

__device__ __forceinline__ void phase_lists(const Params& p) {
  const uint32_t* sel = (const uint32_t*)(p.ws + OFF_SEL);
  uint16_t* lists = (uint16_t*)(p.ws + SLOT(7));
  int* cnt = (int*)(p.ws + OFF_CNT);
  const int lane = threadIdx.x & 63;
  const int wg = blockIdx.x * 4 + (threadIdx.x >> 6), nw = gridDim.x * 4;
  for (int unit = wg; unit < 64 * 31; unit += nw) {
    const int bh = unit / 31, n = unit - bh * 31;
    uint16_t* lp = lists + (size_t)bh * 126976 + list_off(n);
    int base = 0;
    uint4 s4n = *(const uint4*)(sel + (size_t)bh * T_ + (n + 1) * 256 + lane * 4);
    for (int t0 = (n + 1) * 256; t0 < T_; t0 += 256) {
      const uint4 s4 = s4n;
      if (t0 + 256 < T_) s4n = *(const uint4*)(sel + (size_t)bh * T_ + t0 + 256 + lane * 4);
      const uint32_t sv[4] = {s4.x, s4.y, s4.z, s4.w};
#pragma unroll
      for (int q = 0; q < 4; ++q) {
        const int t = t0 + lane * 4 + q;
        const uint32_t s = sv[q];
        int j = -1;
        if ((int)(s & 255u) == n) j = 0;
        else if ((int)((s >> 8) & 255u) == n) j = 1;
        else if ((int)((s >> 16) & 255u) == n) j = 2;
        const unsigned long long mask = __ballot(j >= 0);
        if (j >= 0) {
          int pos = base + __popcll(mask & ((1ull << lane) - 1ull));
          lp[pos] = (uint16_t)(t | (j << 13));
        }
        base += __popcll(mask);
      }
    }
    if (lane == 0) cnt[unit] = base;
  }
}

__device__ __forceinline__ void load_kv_block(const bf16_t* Kblk, const bf16_t* Vtblk, unsigned char* smem) {
  const int tid = fresh_tid();
  {
    const int c8 = tid & 7, r32 = tid >> 3;
#pragma unroll
    for (int pp = 0; pp < 8; ++pp) {
      int row = r32 + 32 * pp;
      uint4 v = *(const uint4*)(Kblk + (size_t)row * 64 + c8 * 8);
      *(uint4*)(smem + sw_off(row, c8)) = v;
    }
  }
  {
    const int c32 = tid & 31, r8 = tid >> 5;
#pragma unroll
    for (int pp = 0; pp < 8; ++pp) {
      int row = r8 + 8 * pp;
      uint4 v = *(const uint4*)(Vtblk + (size_t)row * T_ + c32 * 8);
      unsigned char* d = smem + 32768 + row * 520 + c32 * 16;
      *(uint2*)d = make_uint2(v.x, v.y);
      *(uint2*)(d + 8) = make_uint2(v.z, v.w);
    }
  }
}

struct KVRegs { u32x4 k[8], v[8]; };
__device__ __forceinline__ void kv_gload(const bf16_t* Kblk, const bf16_t* Vtblk, KVRegs& r) {
  const int tid = fresh_tid();
  const int c8 = tid & 7, r32 = tid >> 3, c32 = tid & 31, r8 = tid >> 5;
#pragma unroll
  for (int pp = 0; pp < 8; ++pp) {
    r.k[pp] = *(const u32x4*)(Kblk + (size_t)(r32 + 32 * pp) * 64 + c8 * 8);
    r.v[pp] = *(const u32x4*)(Vtblk + (size_t)(r8 + 8 * pp) * T_ + c32 * 8);
  }
}
__device__ __forceinline__ void kv_lstore(const KVRegs& r, unsigned char* smem) {
  const int tid = fresh_tid();
  const int c8 = tid & 7, r32 = tid >> 3, c32 = tid & 31, r8 = tid >> 5;
#pragma unroll
  for (int pp = 0; pp < 8; ++pp) {
    *(u32x4*)(smem + sw_off(r32 + 32 * pp, c8)) = r.k[pp];
    unsigned char* d = smem + 32768 + (r8 + 8 * pp) * 520 + c32 * 16;
    *(uint2*)d = make_uint2(r.v[pp].x, r.v[pp].y);
    *(uint2*)(d + 8) = make_uint2(r.v[pp].z, r.v[pp].w);
  }
}

template <bool CAUSAL>
__device__ __forceinline__ void attn_wave(const unsigned char* smem, const bf16x8 (&qb)[4], int kt_end, int qpos_rel,
                                          f32x16 (&O)[2], float& m_out, float& l_out) {
  const int lane = fresh_tid() & 63;
  const int c = lane & 31, hh = lane >> 5;
#pragma unroll
  for (int i = 0; i < 2; ++i)
#pragma unroll
    for (int r = 0; r < 16; ++r) O[i][r] = 0.f;
  float m = -1e30f, l = 0.f;
  for (int kt = 0; kt <= kt_end; ++kt) {
    f32x16 s[2];
#pragma unroll
    for (int ti = 0; ti < 2; ++ti) {
#pragma unroll
      for (int r = 0; r < 16; ++r) s[ti][r] = 0.f;
      const int krow = kt * 64 + ti * 32 + c;
#pragma unroll
      for (int ks = 0; ks < 4; ++ks) {
        bf16x8 a = *(const bf16x8*)(smem + sw_off(krow, ks * 2 + hh));
        s[ti] = __builtin_amdgcn_mfma_f32_32x32x16_bf16(a, qb[ks], s[ti], 0, 0, 0);
      }
    }
    float mx = -1e30f;
#pragma unroll
    for (int ti = 0; ti < 2; ++ti)
#pragma unroll
      for (int r = 0; r < 16; ++r) {
        int key = kt * 64 + ti * 32 + (r & 3) + 8 * (r >> 2) + 4 * hh;
        if (CAUSAL && key > qpos_rel) s[ti][r] = -1e30f;
        mx = fmaxf(mx, s[ti][r]);
      }
    mx = fmaxf(mx, __shfl_xor(mx, 32));
    const float mn = fmaxf(m, mx);
    const float alpha = __builtin_amdgcn_exp2f(m - mn);
    m = mn;
    float ps = 0.f;
#pragma unroll
    for (int ti = 0; ti < 2; ++ti)
#pragma unroll
      for (int r = 0; r < 16; ++r) {
        float pv = __builtin_amdgcn_exp2f(s[ti][r] - mn);
        s[ti][r] = pv;
        ps += pv;
      }
    l = l * alpha + ps;
#pragma unroll
    for (int i = 0; i < 2; ++i)
#pragma unroll
      for (int r = 0; r < 16; ++r) O[i][r] *= alpha;
#pragma unroll
    for (int ti = 0; ti < 2; ++ti)
#pragma unroll
      for (int sp = 0; sp < 2; ++sp) {
        union { uint32_t u[4]; bf16x8 v; } pb;
#pragma unroll
        for (int jj = 0; jj < 4; ++jj) pb.u[jj] = pack2(s[ti][8 * sp + 2 * jj], s[ti][8 * sp + 2 * jj + 1]);
        const int keyb = kt * 64 + ti * 32 + 16 * sp + 4 * hh;
#pragma unroll
        for (int dt = 0; dt < 2; ++dt) {
          const unsigned char* vp = smem + 32768 + (dt * 32 + c) * 520 + keyb * 2;
          union { uint2 u[2]; bf16x8 v; } va;
          va.u[0] = *(const uint2*)vp;
          va.u[1] = *(const uint2*)(vp + 16);
          O[dt] = __builtin_amdgcn_mfma_f32_32x32x16_bf16(va.v, pb.v, O[dt], 0, 0, 0);
        }
      }
  }
  l += __shfl_xor(l, 32);
  m_out = m;
  l_out = l;
}

__device__ __forceinline__ void phase_attn_sel(const Params& p, unsigned char* smem) {
  unsigned char* ws = p.ws;
  const bf16_t* Kb = (const bf16_t*)(ws + SLOT(3));
  const bf16_t* Vt = (const bf16_t*)(ws + SLOT(4));
  const bf16_t* Qb = (const bf16_t*)(ws + SLOT(5));
  const uint16_t* lists = (const uint16_t*)(ws + SLOT(7));
  const int* cnt = (const int*)(ws + OFF_CNT);
  float2* ML = (float2*)(ws + OFF_ML);
  const int tid_ = fresh_tid();
  const int lane = tid_ & 63, w = tid_ >> 6;
  const int c = lane & 31, hh = lane >> 5;
  for (int pid = blockIdx.x; pid < 64 * 31 * 8; pid += gridDim.x) {
    const int part = pid / 1984, u = pid - part * 1984;
    const int bh = u / 31, n = u - bh * 31;
    if (part * 8 * 128 >= T_ - (n + 1) * 256) continue;
    const int count = cnt[u];
    const int ntiles = (count + 127) >> 7;
    if (part * 8 >= ntiles) continue;
    const int b = bh >> 4, h = bh & 15;
    __syncthreads();
    load_kv_block(Kb + ((size_t)bh * T_ + n * 256) * 64, Vt + (size_t)bh * 64 * T_ + n * 256, smem);
    __syncthreads();
    const int qend = (part * 8 + 8 < ntiles) ? part * 8 + 8 : ntiles;
    uint32_t ent[8];
    const uint16_t* lp = lists + (size_t)bh * 126976 + list_off(n);
#pragma unroll
    for (int i = 0; i < 8; ++i) {
      int ei = (part * 8 + i) * 128 + 32 * w + c;
      if (ei > count - 1) ei = count - 1;
      ent[i] = lp[ei];
    }
    bf16x8 qn[4];
    {
      const bf16_t* qp = Qb + ((size_t)bh * T_ + (ent[0] & 0x1fff)) * 64;
#pragma unroll
      for (int ks = 0; ks < 4; ++ks) qn[ks] = *(const bf16x8*)(qp + ks * 16 + 8 * hh);
    }
#pragma unroll
    for (int i = 0; i < 8; ++i) {
      const int q = part * 8 + i;
      if (q < qend) {
        const int e0 = q * 128 + 32 * w;
        const uint32_t e = ent[i];
        bf16x8 qb[4];
#pragma unroll
        for (int ks = 0; ks < 4; ++ks) qb[ks] = qn[ks];
        if (i + 1 < 8 && q + 1 < qend) {
          const bf16_t* qp = Qb + ((size_t)bh * T_ + (ent[(i + 1) & 7] & 0x1fff)) * 64;
#pragma unroll
          for (int ks = 0; ks < 4; ++ks) qn[ks] = *(const bf16x8*)(qp + ks * 16 + 8 * hh);
        }
        if (e0 < count) {
          const bool valid = e0 + c < count;
          const int t = e & 0x1fff, j = e >> 13;
          f32x16 O[2];
          float m, l;
          attn_wave<false>(smem, qb, 3, 1 << 30, O, m, l);
          if (valid) {
            const float inv = 1.0f / l;
            unsigned char* reg = opart_region(ws, j, b);
            bf16_t* op = (bf16_t*)reg + ((size_t)h * T_ + t) * 64;
#pragma unroll
            for (int dt = 0; dt < 2; ++dt)
#pragma unroll
              for (int g = 0; g < 4; ++g) {
                uint2 o;
                o.x = pack2(O[dt][4 * g] * inv, O[dt][4 * g + 1] * inv);
                o.y = pack2(O[dt][4 * g + 2] * inv, O[dt][4 * g + 3] * inv);
                *(uint2*)(op + dt * 32 + 8 * g + 4 * hh) = o;
              }
            if (hh == 0) ML[((size_t)j * 64 + bh) * T_ + t] = make_float2(m, l);
          }
        }
      }
    }
  }
}

__device__ __forceinline__ void phase_attn_own(const Params& p, unsigned char* smem) {
  unsigned char* ws = p.ws;
  const bf16_t* Kb = (const bf16_t*)(ws + SLOT(3));
  const bf16_t* Vt = (const bf16_t*)(ws + SLOT(4));
  const bf16_t* Qb = (const bf16_t*)(ws + SLOT(5));
  bf16_t* sgb = (bf16_t*)(ws + SLOT(6));
  const uint32_t* sel = (const uint32_t*)(ws + OFF_SEL);
  const float2* ML = (const float2*)(ws + OFF_ML);
  const int tid_ = fresh_tid();
  const int lane = tid_ & 63, w = tid_ >> 6;
  const int c = lane & 31, hh = lane >> 5;
  KVRegs kvr;
  if ((int)blockIdx.x < 64 * 32 * 2) {
    const int bh0 = blockIdx.x >> 6, cb0 = (blockIdx.x >> 1) & 31;
    kv_gload(Kb + ((size_t)bh0 * T_ + cb0 * 256) * 64, Vt + (size_t)bh0 * 64 * T_ + cb0 * 256, kvr);
  }
  for (int id = blockIdx.x; id < 64 * 32 * 2; id += gridDim.x) {
    const int bh = id >> 6, cb = (id >> 1) & 31, qo = (id & 1) * 128;
    const int b = bh >> 4, h = bh & 15;
    __syncthreads();
    kv_lstore(kvr, smem);
    __syncthreads();
    {
      const int idn = id + gridDim.x;
      if (idn < 64 * 32 * 2) {
        const int bhn = idn >> 6, cbn = (idn >> 1) & 31;
        kv_gload(Kb + ((size_t)bhn * T_ + cbn * 256) * 64, Vt + (size_t)bhn * 64 * T_ + cbn * 256, kvr);
      }
    }
    const int qrel = qo + 32 * w + c;
    const int t = cb * 256 + qrel;
    const bf16_t* qp = Qb + ((size_t)bh * T_ + t) * 64;
    bf16x8 qb[4];
#pragma unroll
    for (int ks = 0; ks < 4; ++ks) qb[ks] = *(const bf16x8*)(qp + ks * 16 + 8 * hh);
    f32x16 O[2];
    float m, l;
    attn_wave<true>(smem, qb, (qo + 32 * w + 31) >> 6, qrel, O, m, l);
    const uint32_t s = sel[(size_t)bh * T_ + t];
    float mj[3], lj[3];
    bool vj[3];
    float Mx = m;
#pragma unroll
    for (int j = 0; j < 3; ++j) {
      vj[j] = ((s >> (8 * j)) & 255u) < 32u;
      float2 ml = ML[((size_t)j * 64 + bh) * T_ + t];
      mj[j] = vj[j] ? ml.x : -1e30f;
      lj[j] = vj[j] ? ml.y : 0.f;
      Mx = fmaxf(Mx, mj[j]);
    }
    const float wo = __builtin_amdgcn_exp2f(m - Mx);
    float den = l * wo;
    float wj[3];
#pragma unroll
    for (int j = 0; j < 3; ++j) {
      wj[j] = vj[j] ? lj[j] * __builtin_amdgcn_exp2f(mj[j] - Mx) : 0.f;
      den += wj[j];
    }
    const float inv = 1.0f / den;
    bf16_t* gp = sgb + ((size_t)(b * T_ + t)) * 1024 + h * 64;
#pragma unroll
    for (int dt = 0; dt < 2; ++dt)
#pragma unroll
      for (int g = 0; g < 4; ++g) {
        const int d0 = dt * 32 + 8 * g + 4 * hh;
        float o0 = O[dt][4 * g] * wo, o1 = O[dt][4 * g + 1] * wo, o2 = O[dt][4 * g + 2] * wo, o3 = O[dt][4 * g + 3] * wo;
#pragma unroll
        for (int j = 0; j < 3; ++j) {
          const bf16_t* op = (const bf16_t*)opart_region(ws, j, b) + ((size_t)h * T_ + t) * 64 + d0;
          uint2 u = *(const uint2*)op;
          if (!vj[j]) u = make_uint2(0u, 0u);
          o0 = fmaf(lo_f(u.x), wj[j], o0); o1 = fmaf(hi_f(u.x), wj[j], o1);
          o2 = fmaf(lo_f(u.y), wj[j], o2); o3 = fmaf(hi_f(u.y), wj[j], o3);
        }
        uint2 gv = *(const uint2*)(gp + d0);
        uint2 r;
        r.x = pack2(o0 * inv * lo_f(gv.x), o1 * inv * hi_f(gv.x));
        r.y = pack2(o2 * inv * lo_f(gv.y), o3 * inv * hi_f(gv.y));
        *(uint2*)(gp + d0) = r;
      }
  }
}

#define XB_TMO      128
#define XB_XCNT(j)  (256  + 64 * (j))
#define XB_XSUB(j)  (1280 + 64 * (j))
#define XB_XGEN(j)  (2304 + 64 * (j))
#define XB_TOP      3328
#define XB_TOPGEN   3392
#define XCD_BAR_WORDS 3456
#define XB_SPIN_CAP (1u << 18)
#define LAS __attribute__((address_space(3)))

__device__ __forceinline__ unsigned xb_ld(unsigned* p)              { return __hip_atomic_load(p, __ATOMIC_RELAXED, __HIP_MEMORY_SCOPE_AGENT); }
__device__ __forceinline__ unsigned xb_add(unsigned* p, unsigned v) { return __hip_atomic_fetch_add(p, v, __ATOMIC_RELAXED, __HIP_MEMORY_SCOPE_AGENT); }
__device__ __forceinline__ unsigned xb_xcc_id() { return (unsigned)__builtin_amdgcn_s_getreg((3 << 11) | 20) & 0xFu; }
#define XB_SPIN(cond, bar) do { unsigned _sp = 0; while (cond) { __builtin_amdgcn_s_sleep(1); \
    if ((++_sp & 255u) == 0u) { if (xb_ld(&(bar)[XB_TMO])) break; if (_sp > XB_SPIN_CAP) { atomicAdd(&(bar)[XB_TMO], 1u); break; } } } } while (0)

struct XcdBarrier {
    unsigned* bar; unsigned x;
    volatile LAS unsigned* st;
};

__device__ __forceinline__ XcdBarrier xcd_barrier_post(unsigned* bar, volatile LAS unsigned* st) {
    XcdBarrier b; b.bar = bar; b.x = xb_xcc_id(); b.st = st;
    if (threadIdx.x == 0) (void)xb_add(&bar[XB_XCNT(b.x)], 1u);
    return b;
}
__device__ __forceinline__ void xcd_barrier_complete(unsigned* bar, unsigned x, unsigned& nloc, unsigned& nx) {
    const unsigned G = gridDim.x * gridDim.y * gridDim.z;
    unsigned sum, cnt, mine, sp = 0u;
    for (;;) {
        sum = 0u; cnt = 0u; mine = 0u;
#pragma unroll
        for (unsigned j = 0; j < 16; ++j) { const unsigned c = xb_ld(&bar[XB_XCNT(j)]); sum += c; cnt += (c > 0u) ? 1u : 0u; mine = (j == x) ? c : mine; }
        if (sum == G) break;
        __builtin_amdgcn_s_sleep(1);
        if ((++sp & 255u) == 0u) { if (xb_ld(&bar[XB_TMO])) break; if (sp > XB_SPIN_CAP) { atomicAdd(&bar[XB_TMO], 1u); break; } }
    }
    nloc = mine > 0u ? mine : 1u; nx = cnt > 0u ? cnt : 1u;
}

__device__ __forceinline__ void xcd_barrier(const XcdBarrier& b) {
    asm volatile("s_waitcnt vmcnt(0)" ::: "memory");
    __syncthreads();
    if (threadIdx.x == 0) {
        unsigned* bar = b.bar;
        __builtin_amdgcn_s_waitcnt(0);
        unsigned nloc = b.st[0], nx = b.st[1];
        if (nloc == 0u) { xcd_barrier_complete(bar, b.x, nloc, nx); b.st[0] = nloc; b.st[1] = nx; }
        const unsigned old = xb_add(&bar[XB_XSUB(b.x)], 1u);
        const unsigned gen = old / nloc;
        if (old + 1u == (gen + 1u) * nloc) {
            __builtin_amdgcn_fence(__ATOMIC_RELEASE, "agent");
            asm volatile("s_waitcnt vmcnt(0)" ::: "memory");
            const unsigned og = xb_add(&bar[XB_TOP], 1u);
            const unsigned tg = og / nx;
            if (og + 1u == (tg + 1u) * nx) xb_add(&bar[XB_TOPGEN], 1u);
            else XB_SPIN(xb_ld(&bar[XB_TOPGEN]) == tg, bar);
            __builtin_amdgcn_fence(__ATOMIC_ACQUIRE, "agent");
            xb_add(&bar[XB_XGEN(b.x)], 1u);
            asm volatile("s_waitcnt vmcnt(0)" ::: "memory");
        } else {
            XB_SPIN(xb_ld(&bar[XB_XGEN(b.x)]) == gen, bar);
            __builtin_amdgcn_fence(__ATOMIC_ACQUIRE, "agent");
            asm volatile("s_waitcnt vmcnt(0)" ::: "memory");
        }
    }
    __syncthreads();
}

__global__ void __launch_bounds__(NTHREADS, 2) yoco_fwd(Params p) {
  cg::grid_group grid = cg::this_grid();
  extern __shared__ __attribute__((aligned(16))) unsigned char smem[];
  unsigned char* ws = p.ws;
  const int tid = threadIdx.x;
  __shared__ uint4 xb_words;
  if (tid == 0) xb_words = make_uint4(0u, 0u, 0u, 0u);
  __syncthreads();
  XcdBarrier xb = xcd_barrier_post((unsigned*)(ws + OFF_BAR), (volatile LAS unsigned*)&xb_words);

  {
    float* tl = (float*)smem;
    const bool defer_b = gridDim.x >= 512;
    for (int j = blockIdx.x; j < 2624 + 64; j += gridDim.x) {
      if (defer_b && j >= 1312 && j < 2592) continue;
      if (j < 1056) transpose_job(p.w_in_a, 4224, 1024, (bf16_t*)(ws + OFF_WT_IN_A), nullptr, j, tl);
      else if (j < 1312) transpose_job(p.w_out_a, 1024, 1024, (bf16_t*)(ws + OFF_WT_OUT_A), nullptr, j - 1056, tl);
      else if (j < 1824) transpose_job(p.w_kv, 2048, 1024, (bf16_t*)(ws + OFF_WT_KVQ), p.norm_kv, j - 1312, tl);
      else if (j < 2336) transpose_job(p.w_in_b, 2048, 1024, (bf16_t*)(ws + OFF_WT_KVQ) + (size_t)2048 * 1024, p.norm_b, j - 1824, tl);
      else if (j < 2592) transpose_job(p.w_out_b, 1024, 1024, (bf16_t*)(ws + OFF_WT_OUT_B), nullptr, j - 2336, tl);
      else if (j < 2608) transpose_job(p.w2, 1024, 64, (bf16_t*)(ws + OFF_W2T), nullptr, j - 2592, tl);
      else if (j < 2624) transpose_job(p.a2, 1024, 64, (bf16_t*)(ws + OFF_A2T), nullptr, j - 2608, tl);
      else {
        const int q = j - 2624;
        const int grp = q >> 5, half = (q >> 4) & 1, kt = q & 15;
        transpose_tile(p.w_in_a, 4224, kt * 64, grp == 0 ? 1024 : 3136, (bf16_t*)(ws + OFF_WT_SMALL), 2048, grp * 64, half * 1024,
                       p.mu_a + (grp == 0 ? 1 : 4) * 1024, half == 0 ? 2 : 1, tl);
      }
    }
    float2* rope = (float2*)(ws + OFF_ROPE);
    for (int i = blockIdx.x * NTHREADS + tid; i < T_ * 8; i += gridDim.x * NTHREADS) {
      const int t = i >> 3, f = i & 7;
      const double invf[8] = {1.0, 0.19392274474868576, 0.03760603093086393, 0.007292664737217109,
                              0.001414213562373095, 0.0002742481756762073, 5.318295896944988e-05, 1.031338537721246e-05};
      double fr = 0.0;
      fr = (f == 0) ? invf[0] : fr; fr = (f == 1) ? invf[1] : fr; fr = (f == 2) ? invf[2] : fr; fr = (f == 3) ? invf[3] : fr;
      fr = (f == 4) ? invf[4] : fr; fr = (f == 5) ? invf[5] : fr; fr = (f == 6) ? invf[6] : fr; fr = (f == 7) ? invf[7] : fr;
      double ang = (double)((float)t * (float)fr);
      double rev = ang * 0.15915494309189535;
      rev = rev - floor(rev + 0.5);
      float rr = (float)(rev * 6.283185307179586);
      rope[i] = make_float2(__cosf(rr), __sinf(rr));
    }
    norm_mix_rows(p);
  }
  if (p.ws == nullptr) grid.sync();
  xcd_barrier(xb);
  phase_gemm1(p, smem);
  xcd_barrier(xb);
  phase_prep2(p);
  xcd_barrier(xb);
  phase_scan1_mfma(p, smem);
  xcd_barrier(xb);
  phase_scan2(p, smem);
  xcd_barrier(xb);
  phase_scan3_mfma(p, smem);
  xcd_barrier(xb);
  phase_gemm_res((const bf16_t*)(ws + SLOT(7)), (const bf16_t*)(ws + OFF_WT_OUT_A), p.x, p.out, smem);
  xcd_barrier(xb);
  rmsnorm_rows(p.out, nullptr, (bf16_t*)(ws + SLOT(1)));
  xcd_barrier(xb);
  phase_gemm_kvq(p, smem);
  xcd_barrier(xb);
  phase_gate(p, smem);
  xcd_barrier(xb);
  phase_lists(p);
  xcd_barrier(xb);
  phase_attn_sel(p, smem);
  xcd_barrier(xb);
  phase_attn_own(p, smem);
  xcd_barrier(xb);
  phase_gemm_res((const bf16_t*)(ws + SLOT(6)), (const bf16_t*)(ws + OFF_WT_OUT_B), p.out, p.out, smem);
}

extern "C" void kernel_launch(void* const* d_in, const int* in_sizes, int n_in, void* d_out, int out_size, void* d_ws,
                              size_t ws_size, hipStream_t stream) {
  static int grid_blocks = 0;
  if (!grid_blocks) {
    int dev = 0, cus = 0, per_cu = 0;
    hipGetDevice(&dev);
    hipDeviceGetAttribute(&cus, hipDeviceAttributeMultiprocessorCount, dev);
    hipFuncSetAttribute((const void*)yoco_fwd, hipFuncAttributeMaxDynamicSharedMemorySize, SMEM_BYTES);
    hipOccupancyMaxActiveBlocksPerMultiprocessor(&per_cu, (const void*)yoco_fwd, NTHREADS, SMEM_BYTES);
    if (per_cu < 1) per_cu = 1;
    if (per_cu > 2) per_cu = 2;
    grid_blocks = cus * per_cu;
    if (ws_size < SLOT(8)) fprintf(stderr, "workspace too small: %zu\n", ws_size);
  }
  (void)hipMemsetAsync((unsigned char*)d_ws + OFF_BAR, 0, XCD_BAR_WORDS * 4, stream);
  Params p{};
  const float** pp = (const float**)&p;
  for (int i = 0; i < 21; ++i) pp[i] = (const float*)d_in[i];
  p.out = (float*)d_out;
  p.ws = (unsigned char*)d_ws;
  void* args[] = {&p};
  hipError_t e = hipLaunchCooperativeKernel((const void*)yoco_fwd, dim3(grid_blocks), dim3(NTHREADS), args, SMEM_BYTES, stream);
  if (e != hipSuccess) fprintf(stderr, "cooperative launch failed: %s (grid %d)\n", hipGetErrorString(e), grid_blocks);
}
```
